# Optimizing an MI355X kernel written in HIP

```python
import math
import jax, jax.numpy as jnp
from jax import lax
import numpy as np

D_MODEL = 2048
BATCH = 2
SEQ = 8192
DEPTH = 2

CONV_CH = 1024
CONV_K = 31
N_ATT_HEADS = 4
ATT_HD = 128
ATT_QK = N_ATT_HEADS * 2 * ATT_HD
ATT_V = N_ATT_HEADS * 2 * ATT_HD
MIX_IN = 2 * CONV_CH + 2 * ATT_QK + ATT_V + 2 * D_MODEL
MEM_LEN = 256
N_MEM_HEADS = 4
MEM_HD = 128
MEM_W = N_MEM_HEADS * MEM_HD
D_FF = 5632
QBLK = 128
ROPE_THETA = 10000.0
EPS = 1e-6
LN_EPS = 1e-5

kernel_name = "hybrid_conformer_diffattn_block"


def rmsnorm(x, g):
    xf = x.astype(jnp.float32)
    y = xf * lax.rsqrt(jnp.mean(xf * xf, axis=-1, keepdims=True) + EPS)
    return (y * g.astype(jnp.float32)).astype(x.dtype)


def swiglu_ffn(x, g, w_in, w_out):
    h = rmsnorm(x, g) @ w_in
    a, b = jnp.split(h, 2, axis=-1)
    return (jax.nn.silu(a) * b) @ w_out


def rope(t, cos, sin):
    tf = t.astype(jnp.float32)
    t1, t2 = jnp.split(tf, 2, axis=-1)
    out = jnp.concatenate([t1 * cos - t2 * sin, t2 * cos + t1 * sin], axis=-1)
    return out.astype(t.dtype)


def conv_branch(u, conv_w, conv_b, ln_g, ln_b, w_out):
    a, b = jnp.split(u, 2, axis=-1)
    g = a * jax.nn.sigmoid(b)
    y = lax.conv_general_dilated(
        g, conv_w[:, None, :], window_strides=(1,), padding=((CONV_K - 1, 0),),
        dimension_numbers=("NWC", "WIO", "NWC"), feature_group_count=CONV_CH)
    y = y + conv_b
    yf = y.astype(jnp.float32)
    mu = jnp.mean(yf, axis=-1, keepdims=True)
    var = jnp.mean(jnp.square(yf - mu), axis=-1, keepdims=True)
    yf = (yf - mu) * lax.rsqrt(var + LN_EPS) * ln_g.astype(jnp.float32) + ln_b.astype(jnp.float32)
    y = jax.nn.silu(yf).astype(u.dtype)
    return y @ w_out


def diff_attention(q, k, v, lam):
    B, S = q.shape[0], q.shape[1]
    nblk = S // QBLK
    qb = q.reshape(B, nblk, QBLK, N_ATT_HEADS, 2, ATT_HD).transpose(1, 0, 2, 3, 4, 5)
    kf = k.astype(jnp.float32)
    key_pos = jnp.arange(S, dtype=jnp.int32)

    def block(args):
        qi, bi = args
        s = jnp.einsum("bqhmd,bkhmd->bhmqk", qi.astype(jnp.float32), kf)
        q_pos = bi * QBLK + jnp.arange(QBLK, dtype=jnp.int32)
        mask = key_pos[None, :] <= q_pos[:, None]
        s = jnp.where(mask, s, -jnp.inf)
        p = jax.nn.softmax(s, axis=-1)
        a = p[:, :, 0] - lam * p[:, :, 1]
        return jnp.einsum("bhqk,bkhe->bqhe", a.astype(v.dtype), v)

    out = lax.map(block, (qb, jnp.arange(nblk, dtype=jnp.int32)))
    return out.transpose(1, 0, 2, 3, 4).reshape(B, S, N_ATT_HEADS, 2 * ATT_HD)


def cross_attention(x, mem, g_x, g_m, w_q, w_kv, w_o):
    B, S = x.shape[0], x.shape[1]
    q = (rmsnorm(x, g_x) @ w_q).reshape(B, S, N_MEM_HEADS, MEM_HD)
    kv = rmsnorm(mem, g_m) @ w_kv
    k, v = jnp.split(kv, 2, axis=-1)
    k = k.reshape(B, MEM_LEN, N_MEM_HEADS, MEM_HD)
    v = v.reshape(B, MEM_LEN, N_MEM_HEADS, MEM_HD)
    s = jnp.einsum("bqhd,bkhd->bhqk", q.astype(jnp.float32), k.astype(jnp.float32)) * (MEM_HD ** -0.5)
    p = jax.nn.softmax(s, axis=-1)
    o = jnp.einsum("bhqk,bkhd->bqhd", p.astype(v.dtype), v).reshape(B, S, MEM_W)
    return o @ w_o


def setup_inputs(seed: int = 0) -> dict:
    key = jax.random.key(seed)
    ks = iter(jax.random.split(key, 40))
    f32 = jnp.float32

    def w(shape, fan_in):
        return jax.random.normal(next(ks), shape, f32) * (fan_in ** -0.5)

    def gain(shape):
        return 1.0 + 0.02 * jax.random.normal(next(ks), shape, f32)

    def small(shape):
        return 0.01 * jax.random.normal(next(ks), shape, f32)

    L = DEPTH
    x = jax.random.normal(next(ks), (BATCH, SEQ, D_MODEL), f32)
    mem = jax.random.normal(next(ks), (BATCH, MEM_LEN, D_MODEL), f32)
    positions = jnp.tile(jnp.arange(SEQ, dtype=jnp.int32)[None, :], (BATCH, 1))
    return {
        "x": x,
        "mem": mem,
        "positions": positions,
        "ffn1_norm": gain((L, D_MODEL)),
        "ffn1_w_in": w((L, D_MODEL, 2 * D_FF), D_MODEL),
        "ffn1_w_out": w((L, D_FF, D_MODEL), D_FF),
        "mix_norm": gain((L, D_MODEL)),
        "mix_w_in": w((L, D_MODEL, MIX_IN), D_MODEL),
        "conv_w": w((L, CONV_K, CONV_CH), CONV_K),
        "conv_b": small((L, CONV_CH)),
        "conv_ln_g": gain((L, CONV_CH)),
        "conv_ln_b": small((L, CONV_CH)),
        "conv_w_out": w((L, CONV_CH, D_MODEL), CONV_CH),
        "diff_lambda": 0.1 * jax.random.normal(next(ks), (L, 4, ATT_HD), f32),
        "diff_subln_g": gain((L, 2 * ATT_HD)),
        "diff_w_out": w((L, ATT_V, D_MODEL), ATT_V),
        "mix_w_out": w((L, D_MODEL, D_MODEL), D_MODEL),
        "cross_norm": gain((L, D_MODEL)),
        "mem_norm": gain((L, D_MODEL)),
        "cross_w_q": w((L, D_MODEL, MEM_W), D_MODEL),
        "cross_w_kv": w((L, D_MODEL, 2 * MEM_W), D_MODEL),
        "cross_w_o": w((L, MEM_W, D_MODEL), MEM_W),
        "ffn2_norm": gain((L, D_MODEL)),
        "ffn2_w_in": w((L, D_MODEL, 2 * D_FF), D_MODEL),
        "ffn2_w_out": w((L, D_FF, D_MODEL), D_FF),
        "final_norm": gain((D_MODEL,)),
    }


def reference(x, mem, positions, ffn1_norm, ffn1_w_in, ffn1_w_out, mix_norm, mix_w_in,
              conv_w, conv_b, conv_ln_g, conv_ln_b, conv_w_out, diff_lambda, diff_subln_g,
              diff_w_out, mix_w_out, cross_norm, mem_norm, cross_w_q, cross_w_kv, cross_w_o,
              ffn2_norm, ffn2_w_in, ffn2_w_out, final_norm):
    B, S = x.shape[0], x.shape[1]
    inv_freq = ROPE_THETA ** (-jnp.arange(0, ATT_HD, 2, dtype=jnp.float32) / ATT_HD)
    ang = positions.astype(jnp.float32)[..., None] * inv_freq
    cos = jnp.cos(ang)[:, :, None, None, :]
    sin = jnp.sin(ang)[:, :, None, None, :]
    splits = [2 * CONV_CH,
              2 * CONV_CH + ATT_QK,
              2 * CONV_CH + 2 * ATT_QK,
              2 * CONV_CH + 2 * ATT_QK + ATT_V,
              2 * CONV_CH + 2 * ATT_QK + ATT_V + D_MODEL]

    for i in range(DEPTH):
        x = x + 0.5 * swiglu_ffn(x, ffn1_norm[i], ffn1_w_in[i], ffn1_w_out[i])

        h = rmsnorm(x, mix_norm[i]) @ mix_w_in[i]
        u_conv, q, k, v, g_conv, g_attn = jnp.split(h, splits, axis=-1)

        y_conv = conv_branch(u_conv, conv_w[i], conv_b[i], conv_ln_g[i], conv_ln_b[i], conv_w_out[i])

        q = rope(q.reshape(B, S, N_ATT_HEADS, 2, ATT_HD), cos, sin) * (ATT_HD ** -0.5)
        k = rope(k.reshape(B, S, N_ATT_HEADS, 2, ATT_HD), cos, sin)
        v = v.reshape(B, S, N_ATT_HEADS, 2 * ATT_HD)
        lam_init = 0.8 - 0.6 * math.exp(-0.3 * i)
        lp = diff_lambda[i].astype(jnp.float32)
        lam = jnp.exp(jnp.sum(lp[0] * lp[1])) - jnp.exp(jnp.sum(lp[2] * lp[3])) + lam_init
        o = diff_attention(q, k, v, lam)
        o = rmsnorm(o, diff_subln_g[i]) * (1.0 - lam_init)
        y_attn = o.reshape(B, S, ATT_V) @ diff_w_out[i]

        merged = jax.nn.sigmoid(g_conv) * y_conv + jax.nn.sigmoid(g_attn) * y_attn
        x = x + merged @ mix_w_out[i]

        x = x + cross_attention(x, mem, cross_norm[i], mem_norm[i], cross_w_q[i], cross_w_kv[i], cross_w_o[i])

        x = x + 0.5 * swiglu_ffn(x, ffn2_norm[i], ffn2_w_in[i], ffn2_w_out[i])

    return rmsnorm(x, final_norm)
```

```cpp
#include <hip/hip_runtime.h>
#include <hip/hip_bf16.h>
#include <hip/hip_cooperative_groups.h>
#include <cstdio>
#include <cstdint>
namespace cg = cooperative_groups;

#ifndef MK_PER_PHASE
#define MK_PER_PHASE 0
#endif

constexpr int DM = 2048, NBATCH = 2, SEQ = 8192, MROWS = NBATCH * SEQ, DEPTH = 2;
constexpr int CONV_CH = 1024, CONV_K = 31, MIXN = 9216, MEML = 256, MEMW = 512, DFF = 5632;
constexpr float RMS_EPS = 1e-6f, LN_EPS = 1e-5f;

constexpr size_t MiB = (size_t)1 << 20;
constexpr size_t WS_W = 0, WS_WLAYER = 192 * MiB;
constexpr size_t OW_F1I = 0, OW_F1O = 23068672, OW_MI = 34603008, OW_WC = 53477376, OW_WD = 55574528, OW_MO = 57671680,
                 OW_CQ = 61865984, OW_CKV = 62914560, OW_CO = 65011712, OW_F2I = 66060288, OW_F2O = 89128960;
constexpr size_t WS_X = 384 * MiB;
constexpr size_t WS_XN = 512 * MiB;
constexpr size_t WS_BIG = 576 * MiB;
constexpr size_t WS_G = WS_BIG, WS_K = WS_BIG + 32 * MiB, WS_Q = WS_BIG + 64 * MiB, WS_V = WS_BIG + 96 * MiB, WS_GC = WS_BIG + 128 * MiB, WS_GA = WS_BIG + 192 * MiB;
constexpr size_t WS_HID = WS_BIG, WS_MERGED = WS_BIG, WS_OC = WS_Q, WS_CQ = WS_V, WS_CO = WS_V + 16 * MiB;
constexpr size_t WS_YC = 832 * MiB;
constexpr size_t WS_COS = 864 * MiB, WS_SIN = 868 * MiB;
constexpr size_t WS_MEMN = 872 * MiB, WS_MEMKV = 876 * MiB;
constexpr size_t WS_CTL = 877 * MiB;
constexpr size_t WS_SS = WS_CTL + 65536;
constexpr size_t CTL_ZERO_BYTES = 65536;
constexpr size_t WS_END = 879 * MiB;

constexpr int LDS_BYTES = 147456;

typedef unsigned short bf16_t;

__device__ __forceinline__ int opaque_tid() { int t = threadIdx.x; asm volatile("" : "+v"(t)); return t; }

template <int CTRL> __device__ __forceinline__ float dpp_mov(float v) { const int i = __builtin_bit_cast(int, v); return __builtin_bit_cast(float, __builtin_amdgcn_update_dpp(i, i, CTRL, 0xf, 0xf, true)); }
__device__ __forceinline__ float lane_xor1(float v) { return dpp_mov<0xB1>(v); }
__device__ __forceinline__ float wave_sum(float v) {
    v += dpp_mov<0xB1>(v); v += dpp_mov<0x4E>(v); v += dpp_mov<0x141>(v); v += dpp_mov<0x140>(v);
    { auto rr = __builtin_amdgcn_permlane16_swap(__float_as_uint(v), __float_as_uint(v), false, false); v = __uint_as_float(rr[0]) + __uint_as_float(rr[1]); }
    { auto rr = __builtin_amdgcn_permlane32_swap(__float_as_uint(v), __float_as_uint(v), false, false); v = __uint_as_float(rr[0]) + __uint_as_float(rr[1]); }
    return v;
}

#ifndef FUSE_NORM
#define FUSE_NORM 1
#endif

typedef __attribute__((address_space(1))) unsigned char* gptr_t;
#define LAUNDER_G(p) do { gptr_t g_ = (gptr_t)(p); asm volatile("" : "+s"(g_)); (p) = (decltype(p))g_; } while (0)

namespace pg8 {
#define PG8_LAS __attribute__((address_space(3)))
typedef unsigned short bf16_t;
typedef short bf16x8 __attribute__((ext_vector_type(8)));
typedef float f32x4 __attribute__((ext_vector_type(4)));
typedef unsigned u32x4 __attribute__((ext_vector_type(4)));
constexpr int BM = 256, BK = 64, HALF = 128, HTB = HALF * BK * 2  , STAGE_BYTES = 8 * HTB, NXCD = 8, WGM = 8;

__host__ __device__ __forceinline__ int lds_byte(int r, int c) { const int st = (r >> 4) * 2 + (c >> 5), rr = r & 15, cc = c & 31, ob = rr * 64 + cc * 2; return st * 1024 + (ob ^ (((ob >> 9) & 1) << 5)); }
__host__ __device__ __forceinline__ void stage_rc(int b, int& R, int& C) { const int st = b / 1024, sb = b % 1024, swz = sb ^ (((sb >> 9) & 1) << 5); R = (st >> 1) * 16 + swz / 64; C = (st & 1) * 32 + (swz % 64) / 2; }
__host__ __device__ __forceinline__ int perm32(int rho) { const int n = rho >> 4, i = rho & 15; return 8 * (i >> 2) + 4 * n + (i & 3); }

struct Unit { int pm, pn; };
struct Gemm { const bf16_t* A; const bf16_t* Bt; int M, N, K; };

struct StaticOrder {
    int nM, nN, nwg, G, c;
    __host__ __device__ void init(int M, int N, int G_, int c_) { nM = M / BM; nN = N / BM; nwg = nM * nN; G = G_; c = c_; }
    __host__ __device__ bool next(int i, Unit& u) const {
        const long L = (long)i * G + c; if (L >= nwg) return false;
        int wgid = (int)L; { const int q = nwg / NXCD, r = nwg % NXCD, xcd = wgid % NXCD, off = wgid / NXCD; wgid = (xcd < r ? xcd * (q + 1) : r * (q + 1) + (xcd - r) * q) + off; }
        const int nig = WGM * nN, gid = wgid / nig, fm = gid * WGM, gsz = (nM - fm) < WGM ? (nM - fm) : WGM;
        u.pm = fm + ((wgid % nig) % gsz); u.pn = (wgid % nig) / gsz; return true;
    }
    __device__ __forceinline__ void a_ready(const Unit&) const {}
    __device__ __forceinline__ void done(const Unit&) const {}
};
__device__ __forceinline__ unsigned cvt_pk_bf16(float lo, float hi) { unsigned r; asm volatile("v_cvt_pk_bf16_f32 %0, %1, %2" : "=v"(r) : "v"(lo), "v"(hi)); return r; }
template <class Epi, class Sched, bool ALIGN_EPI = false, bool SP2 = false>
__device__ __forceinline__ void gemm_phase(PG8_LAS unsigned char* lds, const Gemm g, const Sched& S, const Epi& E) {
    const int tid = opaque_tid(), wid = __builtin_amdgcn_readfirstlane(tid >> 6), lane = tid & 63, wr = wid >> 2, wc = wid & 3, fr = lane & 15, fq = lane >> 4;
    const int K = g.K, nt = K / BK;
    unsigned voffA[2], voffB[2];
#pragma unroll
    for (int i = 0; i < 2; ++i) { int R, C; stage_rc(tid * 16 + i * 8192, R, C); const int Rb = E.perm ? ((R & ~31) + perm32(R & 31)) : R;
        voffA[i] = (unsigned)(R * K + C) * 2u; voffB[i] = (unsigned)(Rb * K + C) * 2u; }
    const size_t kstep = (size_t)(BK * 2);
    const size_t hstep = (size_t)HALF * K * 2;
    const size_t tstep = 2 * hstep;
    const unsigned ldsw = (unsigned)wid * 1024u;
    const int aoff = lds_byte(wr * 64 + fr, fq * 8), boff = lds_byte(wc * 32 + fr, fq * 8);
#define PG8_SA(b, h) (((b) * 2 + (h)) * HTB)
#define PG8_SB(b, h) ((4 + (b) * 2 + (h)) * HTB)
#define PG8_STAGE(bufoff, gbase, voff) do { _Pragma("unroll") for (int _i = 0; _i < 2; ++_i) \
        __builtin_amdgcn_global_load_lds((const unsigned*)((const char*)(gbase) + (voff)[_i]), (PG8_LAS unsigned*)(lds + (bufoff) + ldsw + _i * 8192), 16, 0, 0); } while (0)
#define PG8_LDA(dst, b, h) do { _Pragma("unroll") for (int m = 0; m < 4; ++m) _Pragma("unroll") for (int k = 0; k < 2; ++k) dst[m][k] = *(const PG8_LAS bf16x8*)(lds + PG8_SA(b, h) + aoff + m * 2048 + k * 1024); } while (0)
#define PG8_LDB(dst, b, h) do { _Pragma("unroll") for (int n = 0; n < 2; ++n) _Pragma("unroll") for (int k = 0; k < 2; ++k) dst[n][k] = *(const PG8_LAS bf16x8*)(lds + PG8_SB(b, h) + boff + n * 2048 + k * 1024); } while (0)
#define PG8_MMA(ai, bj, At, Bt) do { __builtin_amdgcn_s_setprio(1); _Pragma("unroll") for (int m = 0; m < 4; ++m) _Pragma("unroll") for (int n = 0; n < 2; ++n) _Pragma("unroll") for (int k = 0; k < 2; ++k) \
        acc[ai][bj][m][n] = __builtin_amdgcn_mfma_f32_16x16x32_bf16(Bt[n][k], At[m][k], acc[ai][bj][m][n], 0, 0, 0); __builtin_amdgcn_s_setprio(0); } while (0)
#define PG8_WAIT_V(n) asm volatile("s_waitcnt vmcnt(" #n ")" ::: "memory")
#define PG8_WAIT_L(n) asm volatile("s_waitcnt lgkmcnt(" #n ")" ::: "memory")
#define PG8_BAR __builtin_amdgcn_s_barrier()
#define PG8_SCHED __builtin_amdgcn_sched_barrier(0)
    Unit cur, nxt; int ui = 0;
    if (!S.next(0, cur)) return;
    f32x4 acc[2][2][4][2];
#pragma unroll
    for (int a = 0; a < 2; ++a)
#pragma unroll
        for (int b = 0; b < 2; ++b)
#pragma unroll
            for (int m = 0; m < 4; ++m)
#pragma unroll
                for (int n = 0; n < 2; ++n) acc[a][b][m][n] = (f32x4){0.f, 0.f, 0.f, 0.f};
    bf16x8 At[4][2], B0[2][2], B1[2][2];
    const char* cA = (const char*)g.A + (size_t)cur.pm * tstep; const char* cB = (const char*)g.Bt + (size_t)cur.pn * tstep;
    S.a_ready(cur);
    if constexpr (SP2) {
        PG8_STAGE(PG8_SB(0, 0), cB, voffB); PG8_STAGE(PG8_SB(0, 1), cB + hstep, voffB); PG8_STAGE(PG8_SA(0, 0), cA, voffA); PG8_STAGE(PG8_SA(0, 1), cA + hstep, voffA);
        if (wr == 1) PG8_BAR;
        PG8_WAIT_V(2); PG8_BAR;
        PG8_STAGE(PG8_SB(1, 0), cB + kstep, voffB); PG8_STAGE(PG8_SA(1, 0), cA + kstep, voffA); PG8_STAGE(PG8_SB(1, 1), cB + hstep + kstep, voffB);
        PG8_WAIT_V(6); PG8_BAR;
    } else {
        PG8_STAGE(PG8_SB(0, 0), cB, voffB); PG8_STAGE(PG8_SA(0, 0), cA, voffA); PG8_STAGE(PG8_SB(0, 1), cB + hstep, voffB); PG8_STAGE(PG8_SA(0, 1), cA + hstep, voffA);
        if (wr == 1) PG8_BAR;
        PG8_WAIT_V(4); PG8_BAR;
        PG8_STAGE(PG8_SB(1, 0), cB + kstep, voffB); PG8_STAGE(PG8_SA(1, 0), cA + kstep, voffA); PG8_STAGE(PG8_SB(1, 1), cB + hstep + kstep, voffB);
        PG8_WAIT_V(6); PG8_BAR;
    }
    for (;;) {
        const bool has_next = S.next(ui + 1, nxt);
        const char* nA = has_next ? (const char*)g.A + (size_t)nxt.pm * tstep : cA; const char* nB = has_next ? (const char*)g.Bt + (size_t)nxt.pn * tstep : cB;
        for (int t = 0; t < nt; t += 2) {
            const bool last = (t == nt - 2);
            const char* a1 = cA + (size_t)(t + 1) * kstep;
            const char* a2 = last ? nA : cA + (size_t)(t + 2) * kstep; const char* b2 = last ? nB : cB + (size_t)(t + 2) * kstep;
            const char* a3 = a2 + kstep; const char* b3 = b2 + kstep;
            if (last && has_next) S.a_ready(nxt);
            if constexpr (SP2) {
            PG8_LDB(B0, 0, 0); PG8_LDB(B1, 0, 1); PG8_SCHED; PG8_LDA(At, 0, 0); PG8_STAGE(PG8_SA(1, 1), a1 + hstep, voffA);
            PG8_WAIT_V(8); PG8_WAIT_L(0); PG8_BAR; PG8_MMA(0, 0, At, B0); PG8_MMA(0, 1, At, B1); PG8_BAR; PG8_SCHED;
            PG8_LDA(At, 0, 1); PG8_STAGE(PG8_SB(0, 0), b2, voffB); PG8_STAGE(PG8_SB(0, 1), b2 + hstep, voffB); PG8_STAGE(PG8_SA(0, 0), a2, voffA);
            PG8_WAIT_V(8); PG8_WAIT_L(0); PG8_BAR; PG8_MMA(1, 0, At, B0); PG8_MMA(1, 1, At, B1); PG8_BAR; PG8_SCHED;
            PG8_LDB(B0, 1, 0); PG8_LDB(B1, 1, 1); PG8_SCHED; PG8_LDA(At, 1, 0); PG8_STAGE(PG8_SA(0, 1), a2 + hstep, voffA);
            PG8_WAIT_V(8); PG8_WAIT_L(0); PG8_BAR; PG8_MMA(0, 0, At, B0); PG8_MMA(0, 1, At, B1); PG8_BAR; PG8_SCHED;
            PG8_LDA(At, 1, 1); PG8_STAGE(PG8_SB(1, 0), b3, voffB); PG8_STAGE(PG8_SB(1, 1), b3 + hstep, voffB); PG8_STAGE(PG8_SA(1, 0), a3, voffA);
            PG8_WAIT_V(8); PG8_WAIT_L(0); PG8_BAR; PG8_MMA(1, 0, At, B0); PG8_MMA(1, 1, At, B1); PG8_BAR; PG8_SCHED;
            } else {
            PG8_LDB(B0, 0, 0); PG8_SCHED; PG8_LDA(At, 0, 0); PG8_STAGE(PG8_SA(1, 1), a1 + hstep, voffA);
            PG8_WAIT_L(8); PG8_BAR; PG8_WAIT_L(0); PG8_MMA(0, 0, At, B0); PG8_BAR; PG8_SCHED;
            PG8_LDB(B1, 0, 1); PG8_STAGE(PG8_SB(0, 0), b2, voffB);
            PG8_BAR; PG8_WAIT_L(0); PG8_MMA(0, 1, At, B1); PG8_BAR;
            PG8_LDA(At, 0, 1); PG8_STAGE(PG8_SA(0, 0), a2, voffA);
            PG8_BAR; PG8_WAIT_L(0); PG8_MMA(1, 0, At, B0); PG8_BAR; PG8_SCHED;
            PG8_STAGE(PG8_SB(0, 1), b2 + hstep, voffB);
            PG8_WAIT_V(6); PG8_BAR; PG8_MMA(1, 1, At, B1); PG8_BAR;
            PG8_LDB(B0, 1, 0); PG8_SCHED; PG8_LDA(At, 1, 0); PG8_STAGE(PG8_SA(0, 1), a2 + hstep, voffA);
            PG8_WAIT_L(8); PG8_BAR; PG8_WAIT_L(0); PG8_MMA(0, 0, At, B0); PG8_BAR; PG8_SCHED;
            PG8_LDB(B1, 1, 1); PG8_STAGE(PG8_SB(1, 0), b3, voffB);
            PG8_BAR; PG8_WAIT_L(0); PG8_MMA(0, 1, At, B1); PG8_BAR;
            PG8_LDA(At, 1, 1); PG8_STAGE(PG8_SA(1, 0), a3, voffA);
            PG8_BAR; PG8_WAIT_L(0); PG8_MMA(1, 0, At, B0); PG8_BAR; PG8_SCHED;
            PG8_STAGE(PG8_SB(1, 1), b3 + hstep, voffB);
            PG8_WAIT_V(6); PG8_BAR; PG8_MMA(1, 1, At, B1); PG8_BAR;
            }
        }
        if constexpr (ALIGN_EPI) { if (wr == 0) PG8_BAR; }
        E(acc, cur, wr, wc, fr, fq);
        if (!has_next) break;
#pragma unroll
        for (int a = 0; a < 2; ++a)
#pragma unroll
            for (int b = 0; b < 2; ++b)
#pragma unroll
                for (int m = 0; m < 4; ++m)
#pragma unroll
                    for (int n = 0; n < 2; ++n) acc[a][b][m][n] = (f32x4){0.f, 0.f, 0.f, 0.f};
        cur = nxt; cA = nA; cB = nB; ++ui;
        if constexpr (ALIGN_EPI) { if (wr == 1) PG8_BAR; }
    }
    PG8_WAIT_V(0);
    if constexpr (!ALIGN_EPI) { if (wr == 0) PG8_BAR; }
    PG8_BAR;

#undef PG8_SA
#undef PG8_SB
#undef PG8_STAGE
#undef PG8_LDA
#undef PG8_LDB
#undef PG8_MMA
#undef PG8_WAIT_V
#undef PG8_WAIT_L
#undef PG8_BAR
#undef PG8_SCHED
}
}

namespace attn {
constexpr int D = 128; constexpr float THR = 8.f; constexpr bool WSKIP = false;
template <int LQ, int LKV, int LO> struct AttnLd { static constexpr int q = LQ, kv = LKV, o = LO; };
constexpr float SCALE = 0.08838834764831845f;
constexpr int NW = 8, QBLK = 32, KVBLK = 64, QB = NW * QBLK;
constexpr int SHM_V = KVBLK * D * 2, SHM_K = KVBLK * D * 2;
constexpr int LDS_BYTES = 2 * SHM_V + 2 * SHM_K + NW * 64 * 4;

using bf16 = __hip_bfloat16;
typedef short bf16x8 __attribute__((ext_vector_type(8)));
typedef short s16x4 __attribute__((ext_vector_type(4)));
typedef float f32x16 __attribute__((ext_vector_type(16)));
typedef float f32x4 __attribute__((ext_vector_type(4)));
typedef unsigned u32x4 __attribute__((ext_vector_type(4)));
template <class A, class Bt> struct same_t { static constexpr bool v = false; };
template <class A> struct same_t<A, A> { static constexpr bool v = true; };

#define KSWZ(row, colB) ((row) * 256 + ((colB) ^ (((row) & 7) << 4)))
#define SBAR() __builtin_amdgcn_sched_barrier(0)
__device__ __forceinline__ int v_st(int k, int c) { const int kk = (k & ~0xC) | ((k & 4) << 1) | ((k & 8) >> 1); return ((kk >> 3) * 4 + (c >> 5)) * 512 + ((kk & 7) * 32 + (c & 31)) * 2; }
__device__ __forceinline__ int v_rd_base(int lane) { return ((lane & 3) << 3) | (((lane >> 2) & 3) << 6) | (((lane >> 4) & 1) << 5) | (((lane >> 5) & 1) << 8); }
constexpr int v_rd_off(int d0, int ks, int half) { return d0 * 512 + ks * 4096 + half * 2048; }
__device__ __forceinline__ int crow(int r, int hi) { return (r & 3) + 8 * (r >> 2) + 4 * hi; }
__device__ __forceinline__ unsigned cvtpk(float lo, float hi) {
    unsigned r; asm volatile("v_cvt_pk_bf16_f32 %0, %1, %2" : "=v"(r) : "v"(lo), "v"(hi)); return r;
}
__device__ __forceinline__ bf16x8 pack8(f32x4 a, f32x4 b) {
    u32x4 w = {cvtpk(a[0], a[1]), cvtpk(a[2], a[3]), cvtpk(b[0], b[1]), cvtpk(b[2], b[3])};
    return *reinterpret_cast<bf16x8*>(&w);
}
template <class T> __device__ __forceinline__ bf16x8 load8(const T* p) {
    if constexpr (same_t<T, float>::v) { return pack8(*(const f32x4*)p, *(const f32x4*)(p + 4)); }
    else { return *reinterpret_cast<const bf16x8*>(p); }
}
__device__ __forceinline__ void mask_tile(f32x16& p0, f32x16& p1, int dq, unsigned W) {
    const float NEG = -__builtin_inff();
#pragma unroll
    for (int r = 0; r < 16; ++r) {
        const int c = (r & 3) + 8 * (r >> 2);
        if ((unsigned)(dq - c) >= W) p0[r] = NEG;
        if ((unsigned)(dq - c - 32) >= W) p1[r] = NEG;
    }
}
__device__ __forceinline__ void partialSM(f32x16& p0, f32x16& p1, float& m_reg, float& mn, float& alpha) {
    float pmax = p0[0]; for (int r = 1; r < 16; ++r) pmax = fmaxf(pmax, p0[r]); for (int r = 0; r < 16; ++r) pmax = fmaxf(pmax, p1[r]);
    { auto rr = __builtin_amdgcn_permlane32_swap(__float_as_uint(pmax), __float_as_uint(pmax), false, false);
      pmax = fmaxf(__uint_as_float(rr[0]), __uint_as_float(rr[1])); }
    constexpr float C2 = 1.4426950408889634f * SCALE;
    if (__builtin_expect(__all((pmax - m_reg) * SCALE <= THR), 1)) { mn = m_reg; alpha = 1.f; }
    else { mn = fmaxf(m_reg, pmax); alpha = __builtin_amdgcn_exp2f((m_reg - mn) * C2); m_reg = mn; }
    const float mnL = -mn * C2;
    for (int r = 0; r < 16; ++r) p0[r] = fmaf(p0[r], C2, mnL); for (int r = 0; r < 16; ++r) p1[r] = fmaf(p1[r], C2, mnL);
    for (int r = 0; r < 16; ++r) p0[r] = __builtin_amdgcn_exp2f(p0[r]);
}
__device__ __forceinline__ void finishSM(f32x16& p0, f32x16& p1, float alpha, float& l_reg, bf16x8& pa0, bf16x8& pa1, bf16x8& pa2, bf16x8& pa3) {
    for (int r = 0; r < 16; ++r) p1[r] = __builtin_amdgcn_exp2f(p1[r]);
    float ps = 0; for (int r = 0; r < 16; ++r) ps += p0[r]; for (int r = 0; r < 16; ++r) ps += p1[r];
    { auto rr = __builtin_amdgcn_permlane32_swap(__float_as_uint(ps), __float_as_uint(ps), false, false);
      ps = __uint_as_float(rr[0]) + __uint_as_float(rr[1]); }
    l_reg = l_reg * alpha + ps;
#define PK4(P, B_, OUT) do { unsigned a0 = cvtpk(P[B_+0], P[B_+1]), a1 = cvtpk(P[B_+2], P[B_+3]);                          \
        unsigned b0 = cvtpk(P[B_+4], P[B_+5]), b1 = cvtpk(P[B_+6], P[B_+7]);                                             \
        auto r0 = __builtin_amdgcn_permlane32_swap(a0, b0, false, false); auto r1 = __builtin_amdgcn_permlane32_swap(a1, b1, false, false); \
        u32x4 w = {r0[0], r1[0], r0[1], r1[1]}; OUT = *reinterpret_cast<bf16x8*>(&w); } while (0)
    PK4(p0, 0, pa0); PK4(p0, 8, pa1); PK4(p1, 0, pa2); PK4(p1, 8, pa3);
#undef PK4
}
template <int KB, bool SK>
__device__ __forceinline__ void qkt(f32x16& p0, f32x16& p1, const char* K_lds, int r32, int hi, const bf16x8* qr, bool act) {
    if (SK && !act) { const float NEG = -__builtin_inff();
#pragma unroll
        for (int r = 0; r < 16; ++r) { p0[r] = NEG; p1[r] = NEG; } return; }
    p0 = f32x16{}; p1 = f32x16{};
    const char* kb[4];
#pragma unroll
    for (int dd = 0; dd < 4; ++dd) kb[dd] = K_lds + KB * SHM_K + KSWZ(r32, (dd * 16 + hi * 8) * 2);
#pragma unroll
    for (int d0 = 0; d0 < 8; ++d0) { const char* a = kb[d0 & 3] + (d0 >> 2) * 128;
        bf16x8 b0 = *reinterpret_cast<const bf16x8*>(a);
        bf16x8 b1 = *reinterpret_cast<const bf16x8*>(a + 32 * 256);
        p0 = __builtin_amdgcn_mfma_f32_32x32x16_bf16(b0, qr[d0], p0, 0, 0, 0);
        p1 = __builtin_amdgcn_mfma_f32_32x32x16_bf16(b1, qr[d0], p1, 0, 0, 0); }
}
template <int VB, bool SK>
__device__ __forceinline__ void pv_tile(f32x16* o, int vb0, bf16x8 pa0, bf16x8 pa1, bf16x8 pa2, bf16x8 pa3, bool act) {
    if (SK && !act) return;
#define TRRD(dst, off) asm volatile("ds_read_b64_tr_b16 %0, %1 offset:%2" : "=&v"(dst) : "v"(vb0), "i"(off) : "memory")
#define PV_D0(d0) do { s16x4 l0, l1, l2, l3, h0, h1, h2, h3; constexpr int b_ = VB * SHM_V + v_rd_off(d0, 0, 0);     \
        TRRD(l0, b_); TRRD(h0, b_ + 2048); TRRD(l1, b_ + 4096); TRRD(h1, b_ + 6144); TRRD(l2, b_ + 8192); TRRD(h2, b_ + 10240); TRRD(l3, b_ + 12288); TRRD(h3, b_ + 14336); \
        asm volatile("s_waitcnt lgkmcnt(0)" ::: "memory"); SBAR();                 \
        o[d0] = __builtin_amdgcn_mfma_f32_32x32x16_bf16(pa0, (bf16x8){l0[0], l0[1], l0[2], l0[3], h0[0], h0[1], h0[2], h0[3]}, o[d0], 0, 0, 0);   \
        o[d0] = __builtin_amdgcn_mfma_f32_32x32x16_bf16(pa1, (bf16x8){l1[0], l1[1], l1[2], l1[3], h1[0], h1[1], h1[2], h1[3]}, o[d0], 0, 0, 0);   \
        o[d0] = __builtin_amdgcn_mfma_f32_32x32x16_bf16(pa2, (bf16x8){l2[0], l2[1], l2[2], l2[3], h2[0], h2[1], h2[2], h2[3]}, o[d0], 0, 0, 0);   \
        o[d0] = __builtin_amdgcn_mfma_f32_32x32x16_bf16(pa3, (bf16x8){l3[0], l3[1], l3[2], l3[3], h3[0], h3[1], h3[2], h3[3]}, o[d0], 0, 0, 0); } while (0)
    PV_D0(0); PV_D0(1); PV_D0(2); PV_D0(3);
#undef PV_D0
#undef TRRD
}

template <class TIn, class TOut> struct BlockRef { const TIn* Q; const TIn* K; const TIn* V; TOut* O; int P0; };
template <class TIn> struct Seam {
    bf16x8 qr[8];
    bf16x8 st_v0, st_v1, st_k0, st_k1; f32x4 sf0, sf1, sf2, sf3;
    f32x4 tq[16];
};
__device__ __forceinline__ int swa_jlo(int P0, int W) { const int lowk = P0 - W + 1; return lowk > 0 ? lowk / KVBLK : 0; }
#define ROW(p, k0, rr) ((p) + (size_t)((k0) + (rr)) * ldkv + sc)
#define VMW() asm volatile("s_waitcnt vmcnt(0)" ::: "memory")
#define VMWN(n) asm volatile("s_waitcnt vmcnt(%0)" :: "i"(n) : "memory")
#define SLOAD_H(Kp, Vp, k0) do { S.st_v0 = load8<TIn>(ROW(Vp, k0, sr)); S.st_v1 = load8<TIn>(ROW(Vp, k0, 32 + sr));              \
                         S.st_k0 = load8<TIn>(ROW(Kp, k0, sr)); S.st_k1 = load8<TIn>(ROW(Kp, k0, 32 + sr)); } while (0)
#define SWRITE_HK(bf) do { *(bf16x8*)(K_lds + (bf) * SHM_K + kws) = S.st_k0; *(bf16x8*)(K_lds + (bf) * SHM_K + kws + 32 * 256) = S.st_k1; } while (0)
#define SWRITE_HV(bf) do { *(bf16x8*)(V_lds + (bf) * SHM_V + vst0) = S.st_v0; *(bf16x8*)(V_lds + (bf) * SHM_V + vst1) = S.st_v1; } while (0)
#define SWRITE_H(bf) do { SWRITE_HV(bf); SWRITE_HK(bf); } while (0)
#define SLOAD_F(p, k0) do { S.sf0 = *(const f32x4*)ROW(p, k0, sr); S.sf1 = *(const f32x4*)(ROW(p, k0, sr) + 4);                \
                            S.sf2 = *(const f32x4*)ROW(p, k0, 32 + sr); S.sf3 = *(const f32x4*)(ROW(p, k0, 32 + sr) + 4); } while (0)
#define SWRITE_KF(bf) do { *(bf16x8*)(K_lds + (bf) * SHM_K + kws) = pack8(S.sf0, S.sf1); *(bf16x8*)(K_lds + (bf) * SHM_K + kws + 32 * 256) = pack8(S.sf2, S.sf3); } while (0)
#define SWRITE_VF(bf) do { *(bf16x8*)(V_lds + (bf) * SHM_V + vst0) = pack8(S.sf0, S.sf1); *(bf16x8*)(V_lds + (bf) * SHM_V + vst1) = pack8(S.sf2, S.sf3); } while (0)
template <class TIn, class TOut, class LD>
__device__ __forceinline__ void causal_swa_prime(const BlockRef<TIn, TOut>& cur, int W, char* lds, Seam<TIn>& S, const LD&) {
    constexpr int ldq = LD::q, ldkv = LD::kv; (void)ldq;
    constexpr bool F32 = same_t<TIn, float>::v;
    const int tid = opaque_tid(), wid = __builtin_amdgcn_readfirstlane(tid >> 6), lane = tid & 63, r32 = lane & 31, hi = lane >> 5;
    const int sr = tid >> 4, sc = (tid & 15) * 8, kws = KSWZ(sr, sc * 2); char* K_lds = lds + 2 * SHM_V;
    const int kb0 = swa_jlo(cur.P0, W) * KVBLK;
    for (int d0 = 0; d0 < 8; ++d0) S.qr[d0] = load8<TIn>(cur.Q + (size_t)(wid * QBLK + r32) * ldq + d0 * 16 + hi * 8);
    if constexpr (F32) { SLOAD_F((const float*)cur.K, kb0); VMW(); SWRITE_KF(0); SBAR(); SLOAD_F((const float*)cur.V, kb0); }
    else { SLOAD_H(cur.K, cur.V, kb0); VMW(); SWRITE_HK(0); }
    __syncthreads();
}
template <class TIn, class TOut, class LD>
__device__ __forceinline__ void causal_swa_block(const BlockRef<TIn, TOut>& cur, const BlockRef<TIn, TOut>& nxt, int skv, int W, char* lds, Seam<TIn>& S, const LD&) {
    constexpr int ldq = LD::q, ldkv = LD::kv, ldo = LD::o;
    constexpr bool F32 = same_t<TIn, float>::v;
    const int tid = opaque_tid(), wid = __builtin_amdgcn_readfirstlane(tid >> 6), lane = tid & 63, r32 = lane & 31, hi = lane >> 5;
    const int j_lo = swa_jlo(cur.P0, W);
    int j_hi = (cur.P0 + QB - 1) / KVBLK + 1; if (j_hi > skv / KVBLK) j_hi = skv / KVBLK;
    const int NT = j_hi - j_lo;
    const int kbn = swa_jlo(nxt.P0, W) * KVBLK;
    const int qlo = cur.P0 + wid * QBLK, qm = qlo + r32 - 4 * hi;
    char* V_lds = lds; char* K_lds = lds + 2 * SHM_V;
    float* ws = (float*)(lds + 2 * SHM_V + 2 * SHM_K) + wid * 64; float* li_l = ws, * al_l = ws + 32;
    float m_reg = -1e30f, l_reg = 0; f32x16 o[4] = {};
    const int sr = tid >> 4, sc = (tid & 15) * 8, vst0 = v_st(sr, sc), vst1 = v_st(32 + sr, sc), kws = KSWZ(sr, sc * 2);
    const int vb0 = (int)(uintptr_t)V_lds + v_rd_base(lane);
    const TIn* Kh = cur.K; const TIn* Vh = cur.V;
#define RESC(a) do { if (__any((a) < 1.f)) { if (hi == 0) al_l[r32] = (a); asm volatile("s_waitcnt lgkmcnt(0)" ::: "memory");              \
                     for (int d_ = 0; d_ < 4; ++d_) for (int r = 0; r < 16; ++r) o[d_][r] *= al_l[crow(r, hi)]; } } while (0)
#define KBASE(t) ((j_lo + (t)) * KVBLK)
#define ACT(t) (KBASE(t) <= qlo + QBLK - 1 && KBASE(t) + KVBLK - 1 >= qlo - W + 1)
#define MASKT(P0_, P1_, t) do { const int kb_ = KBASE(t); if ((!SK || ACT(t)) && (kb_ + KVBLK - 1 > qlo || kb_ <= qlo + QBLK - 1 - W)) mask_tile(P0_, P1_, qm - kb_, (unsigned)W); } while (0)
    constexpr int NQL = F32 ? 16 : 8;
    constexpr bool SK = WSKIP && !F32;
#define SEAM_K0() do { VMWN(NQL); if constexpr (F32) { SWRITE_KF(0); SBAR(); SLOAD_F((const float*)nxt.V, kbn); } else { SWRITE_HK(0); } SBAR(); } while (0)
    f32x16 pA0, pA1, pB0, pB1; float mnA, mnB, alA, alB; bf16x8 pa0, pa1, pa2, pa3;
    if constexpr (F32) { VMW(); SWRITE_VF(0); SBAR(); } else { SWRITE_HV(0); SBAR(); }
    if (NT > 1) { if constexpr (F32) SLOAD_F((const float*)Kh, KBASE(1)); else SLOAD_H(Kh, Vh, KBASE(1)); }
    SBAR(); qkt<0, SK>(pA0, pA1, K_lds, r32, hi, S.qr, ACT(0));
    if constexpr (F32) { if (NT > 1) { VMW(); SWRITE_KF(1); SBAR(); SLOAD_F((const float*)Vh, KBASE(1)); } }
    MASKT(pA0, pA1, 0); partialSM(pA0, pA1, m_reg, mnA, alA);
    if (NT > 1) { VMW(); if constexpr (F32) { SWRITE_VF(1); SBAR(); if (NT > 2) SLOAD_F((const float*)Kh, KBASE(2)); } else SWRITE_H(1); }
    __syncthreads();
#define HALF_STEP(PX0, PX1, mnX, alX, PY0, PY1, alY, t, KB, VB, SB) do {                                                      \
        SBAR(); qkt<KB, SK>(PX0, PX1, K_lds, r32, hi, S.qr, ACT(t));                                             \
        finishSM(PY0, PY1, alY, l_reg, pa0, pa1, pa2, pa3); SBAR();                                                           \
        if ((t) + 1 < NT) { if constexpr (F32) { VMW(); SWRITE_KF(SB); SBAR(); SLOAD_F((const float*)Vh, KBASE((t) + 1)); }  \
                            else { SLOAD_H(Kh, Vh, KBASE((t) + 1)); } SBAR(); }                                               \
        pv_tile<VB, SK>(o, vb0, pa0, pa1, pa2, pa3, ACT((t) - 1)); MASKT(PX0, PX1, (t)); partialSM(PX0, PX1, m_reg, mnX, alX);                                        \
        __syncthreads();                                                                                                      \
        if ((t) + 1 < NT) { VMW(); if constexpr (F32) { SWRITE_VF(SB); SBAR(); if ((t) + 2 < NT) SLOAD_F((const float*)Kh, KBASE((t) + 2)); } \
                            else { SWRITE_H(SB); } }                                                                          \
        RESC(alX); __syncthreads(); } while (0)
    for (int t = 1; t + 1 < NT; t += 2) {
        HALF_STEP(pB0, pB1, mnB, alB, pA0, pA1, alA, t, 1, 0, 0);
        HALF_STEP(pA0, pA1, mnA, alA, pB0, pB1, alB, t + 1, 0, 1, 1);
    }
    const bool even = (NT & 1) == 0;
    if (even) { SBAR(); qkt<1, SK>(pB0, pB1, K_lds, r32, hi, S.qr, ACT(NT - 1)); SBAR(); }
#define QROW(e) (nxt.Q + (size_t)(wid * QBLK + r32) * ldq + ((e) >> 1) * 16 + hi * 8 + ((e) & 1) * 4)
    if constexpr (F32) { SLOAD_F((const float*)nxt.K, kbn); SBAR();
#pragma unroll
        for (int e = 0; e < 8; ++e) S.tq[e] = *(const f32x4*)QROW(e); }
    else { SLOAD_H(nxt.K, nxt.V, kbn); SBAR();
#pragma unroll
        for (int d0 = 0; d0 < 8; ++d0) S.qr[d0] = load8<TIn>(nxt.Q + (size_t)(wid * QBLK + r32) * ldq + d0 * 16 + hi * 8); }
    SBAR();
    finishSM(pA0, pA1, alA, l_reg, pa0, pa1, pa2, pa3); SBAR();
    if constexpr (F32) {
#pragma unroll
        for (int e = 8; e < 16; ++e) S.tq[e] = *(const f32x4*)QROW(e); SBAR(); }
#undef QROW
    pv_tile<0, SK>(o, vb0, pa0, pa1, pa2, pa3, ACT(even ? NT - 2 : NT - 1));
    if (even) { MASKT(pB0, pB1, NT - 1); partialSM(pB0, pB1, m_reg, mnB, alB); __syncthreads(); RESC(alB);
        finishSM(pB0, pB1, alB, l_reg, pa0, pa1, pa2, pa3); SBAR(); pv_tile<1, SK>(o, vb0, pa0, pa1, pa2, pa3, ACT(NT - 1)); }
    SBAR(); SEAM_K0();
    if (hi == 0) li_l[r32] = l_reg; asm volatile("s_waitcnt lgkmcnt(0)" ::: "memory");
    float rli[16];
#pragma unroll
    for (int r = 0; r < 16; ++r) rli[r] = __builtin_amdgcn_rcpf(li_l[crow(r, hi)]);
    TOut* Ow = cur.O + (size_t)(wid * QBLK) * ldo;
#pragma unroll
    for (int r = 0; r < 16; ++r) { const int orow = crow(r, hi);
#pragma unroll
        for (int d0 = 0; d0 < 4; ++d0) { const float v = o[d0][r] * rli[r];
            if constexpr (same_t<TOut, float>::v) { Ow[(size_t)orow * ldo + d0 * 32 + r32] = v; }
            else { const float vn = lane_xor1(v);
                   if ((r32 & 1) == 0) *(unsigned*)(Ow + (size_t)orow * ldo + d0 * 32 + r32) = cvtpk(v, vn); } } }
    if constexpr (F32) {
#pragma unroll
        for (int d0 = 0; d0 < 8; ++d0) S.qr[d0] = pack8(S.tq[2 * d0], S.tq[2 * d0 + 1]); }
    __syncthreads();
#undef RESC
#undef KBASE
#undef ACT
#undef MASKT
#undef SEAM_K0
#undef HALF_STEP
}
#undef ROW
#undef VMW
#undef VMWN
#undef SLOAD_H
#undef SWRITE_HK
#undef SWRITE_HV
#undef SWRITE_H
#undef SLOAD_F
#undef SWRITE_KF
#undef SWRITE_VF
#undef KSWZ
#undef SBAR
}

#define LAS __attribute__((address_space(3)))
#define XB_TMO      128
#define XB_XCNT(j)  (256  + 64 * (j))
#define XB_XSUB(j)  (1280 + 64 * (j))
#define XB_XGEN(j)  (2304 + 64 * (j))
#define XB_TOP      3328
#define XB_TOPGEN   3392
#define XCD_BAR_WORDS 3456
#define XB_SPIN_CAP (1u << 18)

__device__ __forceinline__ unsigned xb_ld(unsigned* p)              { return __hip_atomic_load(p, __ATOMIC_RELAXED, __HIP_MEMORY_SCOPE_AGENT); }
__device__ __forceinline__ unsigned xb_add(unsigned* p, unsigned v) { return __hip_atomic_fetch_add(p, v, __ATOMIC_RELAXED, __HIP_MEMORY_SCOPE_AGENT); }
__device__ __forceinline__ unsigned xb_xcc_id() { return (unsigned)__builtin_amdgcn_s_getreg((3 << 11) | 20) & 0xFu; }
#define XB_SPIN(cond, bar) do { unsigned _sp = 0; while (cond) { __builtin_amdgcn_s_sleep(1); \
    if ((++_sp & 255u) == 0u) { if (xb_ld(&(bar)[XB_TMO])) break; if (_sp > XB_SPIN_CAP) { atomicAdd(&(bar)[XB_TMO], 1u); break; } } } } while (0)

struct XcdBarrier {
    unsigned* bar; unsigned x;
    volatile LAS unsigned* st;
};

__device__ __forceinline__ XcdBarrier xcd_barrier_post(unsigned* bar, volatile LAS unsigned* st) {
    XcdBarrier b; b.bar = bar; b.x = xb_xcc_id(); b.st = st;
    if (threadIdx.x == 0) (void)xb_add(&bar[XB_XCNT(b.x)], 1u);
    return b;
}
__device__ __forceinline__ void xcd_barrier_complete(unsigned* bar, unsigned x, unsigned& nloc, unsigned& nx) {
    const unsigned G = gridDim.x * gridDim.y * gridDim.z;
    unsigned sum, cnt, mine, sp = 0u;
    for (;;) {
        sum = 0u; cnt = 0u; mine = 0u;
#pragma unroll
        for (unsigned j = 0; j < 16; ++j) { const unsigned c = xb_ld(&bar[XB_XCNT(j)]); sum += c; cnt += (c > 0u) ? 1u : 0u; mine = (j == x) ? c : mine; }
        if (sum == G) break;
        __builtin_amdgcn_s_sleep(1);
        if ((++sp & 255u) == 0u) { if (xb_ld(&bar[XB_TMO])) break; if (sp > XB_SPIN_CAP) { atomicAdd(&bar[XB_TMO], 1u); break; } }
    }
    nloc = mine > 0u ? mine : 1u; nx = cnt > 0u ? cnt : 1u;
}

__device__ __forceinline__ void xcd_barrier(const XcdBarrier& b) {
    asm volatile("s_waitcnt vmcnt(0)" ::: "memory");
    __syncthreads();
    if (threadIdx.x == 0) {
        unsigned* bar = b.bar;
        __builtin_amdgcn_s_waitcnt(0);
        unsigned nloc = b.st[0], nx = b.st[1];
        if (nloc == 0u) { xcd_barrier_complete(bar, b.x, nloc, nx); b.st[0] = nloc; b.st[1] = nx; }
        const unsigned old = xb_add(&bar[XB_XSUB(b.x)], 1u);
        const unsigned gen = old / nloc;
        if (old + 1u == (gen + 1u) * nloc) {
            __builtin_amdgcn_fence(__ATOMIC_RELEASE, "agent");
            asm volatile("s_waitcnt vmcnt(0)" ::: "memory");
            const unsigned og = xb_add(&bar[XB_TOP], 1u);
            const unsigned tg = og / nx;
            if (og + 1u == (tg + 1u) * nx) xb_add(&bar[XB_TOPGEN], 1u);
            else XB_SPIN(xb_ld(&bar[XB_TOPGEN]) == tg, bar);
            __builtin_amdgcn_fence(__ATOMIC_ACQUIRE, "agent");
            xb_add(&bar[XB_XGEN(b.x)], 1u);
            asm volatile("s_waitcnt vmcnt(0)" ::: "memory");
        } else {
            XB_SPIN(xb_ld(&bar[XB_XGEN(b.x)]) == gen, bar);
            __builtin_amdgcn_fence(__ATOMIC_ACQUIRE, "agent");
            asm volatile("s_waitcnt vmcnt(0)" ::: "memory");
        }
    }
    __syncthreads();
}


typedef float f32x4 __attribute__((ext_vector_type(4)));
typedef unsigned u32x4 __attribute__((ext_vector_type(4)));
typedef unsigned u32x2 __attribute__((ext_vector_type(2)));

typedef float f32x2_t __attribute__((ext_vector_type(2))); typedef __bf16 bf16x2_t __attribute__((ext_vector_type(2)));
__device__ __forceinline__ unsigned pkbf(float lo, float hi) { const f32x2_t v = {lo, hi}; const bf16x2_t b = __builtin_convertvector(v, bf16x2_t); return __builtin_bit_cast(unsigned, b); }
__device__ __forceinline__ float bflo(unsigned w) { return __uint_as_float(w << 16); }
__device__ __forceinline__ float bfhi(unsigned w) { return __uint_as_float(w & 0xffff0000u); }
__device__ __forceinline__ float sigmoidf_(float x) { return __builtin_amdgcn_rcpf(1.0f + __builtin_amdgcn_exp2f(-1.4426950408889634f * x)); }
__device__ __forceinline__ float siluf_(float x) { return x * sigmoidf_(x); }
__device__ __forceinline__ u32x4 pack8(f32x4 a, f32x4 b) { u32x4 w; w.x = pkbf(a[0], a[1]); w.y = pkbf(a[2], a[3]); w.z = pkbf(b[0], b[1]); w.w = pkbf(b[2], b[3]); return w; }
__device__ __forceinline__ void unpack8(u32x4 w, f32x4& a, f32x4& b) { a = (f32x4){bflo(w.x), bfhi(w.x), bflo(w.y), bfhi(w.y)}; b = (f32x4){bflo(w.z), bfhi(w.z), bflo(w.w), bfhi(w.w)}; }

typedef unsigned long long u64_t;
__device__ __forceinline__ float rstd_of(const u64_t* ss, int row) {
    if (!ss) return 1.0f;
    const u64_t v = ss[row]; const float s = ((float)(unsigned)(v >> 32) * 4294967296.0f + (float)(unsigned)v) * (1.0f / 4096.0f);
    return 1.0f / sqrtf(s * (1.0f / DM) + RMS_EPS);
}
__device__ __forceinline__ const void* karg_in(int i);
__device__ __forceinline__ float sum_rows4(float v) {
    { auto rr = __builtin_amdgcn_permlane16_swap(__float_as_uint(v), __float_as_uint(v), false, false); v = __uint_as_float(rr[0]) + __uint_as_float(rr[1]); }
    { auto rr = __builtin_amdgcn_permlane32_swap(__float_as_uint(v), __float_as_uint(v), false, false); v = __uint_as_float(rr[0]) + __uint_as_float(rr[1]); }
    return v;
}
enum { EPI_SWIGLU = 0, EPI_RESID = 1, EPI_MIXIN = 2, EPI_MERGE_A = 3, EPI_MERGE_B = 4, EPI_BF16 = 5 };
struct Epi {
    int mode, perm, ldc, scale2;
    int o16, gate16, ss16, base_in;
    unsigned char* ws;
    __device__ __forceinline__ void operator()(const f32x4 (&acc)[2][2][4][2], const pg8::Unit& u, int wr, int wc, int fr, int fq) const {
        const int row0 = u.pm * 256 + wr * 64 + fr;
#define LAUNDER(p) LAUNDER_G(p)
        u64_t* ss_l = ss16 ? (u64_t*)(ws + ((size_t)ss16 << 16)) : nullptr; LAUNDER(ss_l); u64_t* const ss_out = ss_l;
        float rs[2][4];
        if (mode != EPI_RESID && ss_l) { u64_t sv[2][4];
#pragma unroll
            for (int ai = 0; ai < 2; ++ai)
#pragma unroll
                for (int m = 0; m < 4; ++m) sv[ai][m] = ss_l[row0 + ai * 128 + m * 16];
#pragma unroll
            for (int ai = 0; ai < 2; ++ai)
#pragma unroll
                for (int m = 0; m < 4; ++m) { const u64_t v = sv[ai][m]; const float s = ((float)(unsigned)(v >> 32) * 4294967296.0f + (float)(unsigned)v) * (1.0f / 4096.0f); rs[ai][m] = 1.0f / sqrtf(s * (1.0f / DM) + RMS_EPS); }
        } else {
#pragma unroll
            for (int ai = 0; ai < 2; ++ai)
#pragma unroll
                for (int m = 0; m < 4; ++m) rs[ai][m] = 1.0f;
        }
        if (mode == EPI_RESID) {
            const float* xin = (const float*)karg_in(0); bf16_t* XNB = (bf16_t*)(ws + WS_XN); LAUNDER(xin); LAUNDER(XNB);
            const int col0 = u.pn * 256 + wc * 32 + 4 * fq; const float scale = 0.5f * (float)scale2;
#pragma unroll
            for (int ai = 0; ai < 2; ++ai)
#pragma unroll
              for (int mh = 0; mh < 2; ++mh) {
                f32x4 pre[2][2][2];
                if (base_in) {
#pragma unroll
                    for (int mm = 0; mm < 2; ++mm) { const size_t off = (size_t)(row0 + ai * 128 + (2 * mh + mm) * 16) * DM + col0;
#pragma unroll
                        for (int bj = 0; bj < 2; ++bj)
#pragma unroll
                            for (int n = 0; n < 2; ++n) pre[mm][bj][n] = *(const f32x4*)(xin + off + bj * 128 + n * 16); }
                } else {
                    u32x2 raw[2][2][2];
#pragma unroll
                    for (int mm = 0; mm < 2; ++mm) { const size_t off = (size_t)(row0 + ai * 128 + (2 * mh + mm) * 16) * DM + col0;
#pragma unroll
                        for (int bj = 0; bj < 2; ++bj)
#pragma unroll
                            for (int n = 0; n < 2; ++n) raw[mm][bj][n] = *(const u32x2*)(XNB + off + bj * 128 + n * 16); }
#pragma unroll
                    for (int mm = 0; mm < 2; ++mm)
#pragma unroll
                        for (int bj = 0; bj < 2; ++bj)
#pragma unroll
                            for (int n = 0; n < 2; ++n) { const u32x2 t = raw[mm][bj][n]; pre[mm][bj][n] = (f32x4){bflo(t.x), bfhi(t.x), bflo(t.y), bfhi(t.y)}; }
                }
#pragma unroll
                for (int mm = 0; mm < 2; ++mm) { const int m = 2 * mh + mm; const int row = row0 + ai * 128 + m * 16; const size_t off = (size_t)row * DM + col0; float s = 0.f;
#pragma unroll
                    for (int bj = 0; bj < 2; ++bj)
#pragma unroll
                        for (int n = 0; n < 2; ++n) { const f32x4 v = pre[mm][bj][n] + acc[ai][bj][m][n] * scale;
                            u32x2 w; w.x = pkbf(v[0], v[1]); w.y = pkbf(v[2], v[3]); *(u32x2*)(XNB + off + bj * 128 + n * 16) = w;
                            s += (v[0] * v[0] + v[1] * v[1]) + (v[2] * v[2] + v[3] * v[3]); }
                    s = sum_rows4(s);
                    if (fq == 0) __hip_atomic_fetch_add(ss_out + row, (u64_t)(unsigned)(s * 4096.0f + 0.5f), __ATOMIC_RELAXED, __HIP_MEMORY_SCOPE_AGENT); }
                asm volatile("" ::: "memory");
              }
        } else if (mode == EPI_SWIGLU) {
            bf16_t* O = (bf16_t*)(ws + ((size_t)o16 << 16)); LAUNDER(O);
            const int col = u.pn * 128 + wc * 32 + 8 * fq;
#pragma unroll
            for (int ai = 0; ai < 2; ++ai)
#pragma unroll
                for (int m = 0; m < 4; ++m) { const size_t row = (size_t)(row0 + ai * 128 + m * 16);
                    f32x4 h0, h1;
#pragma unroll
                    for (int e = 0; e < 4; ++e) { const float r = rs[ai][m]; h0[e] = siluf_(acc[ai][0][m][0][e] * r) * (acc[ai][1][m][0][e] * r); h1[e] = siluf_(acc[ai][0][m][1][e] * r) * (acc[ai][1][m][1][e] * r); }
                    *(u32x4*)(O + row * ldc + col) = pack8(h0, h1); }
        } else if (mode == EPI_BF16) {
            bf16_t* O = (bf16_t*)(ws + ((size_t)o16 << 16)); LAUNDER(O);
            const int col0 = u.pn * 256 + wc * 32 + 8 * fq;
#pragma unroll
            for (int ai = 0; ai < 2; ++ai)
#pragma unroll
                for (int m = 0; m < 4; ++m) { const size_t row = (size_t)(row0 + ai * 128 + m * 16);
#pragma unroll
                    for (int bj = 0; bj < 2; ++bj) *(u32x4*)(O + row * ldc + col0 + bj * 128) = pack8(acc[ai][bj][m][0] * rs[ai][m], acc[ai][bj][m][1] * rs[ai][m]); }
        } else if (mode == EPI_MERGE_A || mode == EPI_MERGE_B) {
            bf16_t* O = (bf16_t*)(ws + ((size_t)o16 << 16)); const bf16_t* gate = (const bf16_t*)(ws + ((size_t)gate16 << 16)); LAUNDER(O); LAUNDER(gate);
            const int col0 = u.pn * 256 + wc * 32 + 8 * fq;
#pragma unroll
            for (int ai = 0; ai < 2; ++ai)
#pragma unroll
              for (int mh = 0; mh < 2; ++mh) {
                u32x4 gv[2][2], pv[2][2];
#pragma unroll
                for (int mm = 0; mm < 2; ++mm) { const size_t off = (size_t)(row0 + ai * 128 + (2 * mh + mm) * 16) * DM + col0;
#pragma unroll
                    for (int bj = 0; bj < 2; ++bj) gv[mm][bj] = *(const u32x4*)(gate + off + bj * 128); }
                if (mode == EPI_MERGE_B) {
#pragma unroll
                    for (int mm = 0; mm < 2; ++mm) { const size_t off = (size_t)(row0 + ai * 128 + (2 * mh + mm) * 16) * DM + col0;
#pragma unroll
                        for (int bj = 0; bj < 2; ++bj) pv[mm][bj] = *(const u32x4*)(O + off + bj * 128); }
                } else {
#pragma unroll
                    for (int mm = 0; mm < 2; ++mm)
#pragma unroll
                        for (int bj = 0; bj < 2; ++bj) pv[mm][bj] = (u32x4){0u, 0u, 0u, 0u};
                }
#pragma unroll
                for (int mm = 0; mm < 2; ++mm) { const int m = 2 * mh + mm; const size_t off = (size_t)(row0 + ai * 128 + m * 16) * DM + col0;
#pragma unroll
                    for (int bj = 0; bj < 2; ++bj) { f32x4 g0, g1, p0, p1; unpack8(gv[mm][bj], g0, g1); unpack8(pv[mm][bj], p0, p1);
                        *(u32x4*)(O + off + bj * 128) = pack8(acc[ai][bj][m][0] * g0 + p0, acc[ai][bj][m][1] * g1 + p1); } }
                asm volatile("" ::: "memory");
              }
        } else {
            const int pn = u.pn, tc = wc * 32 + 8 * fq;
            if (pn < 8) {
                bf16_t* G = (bf16_t*)(ws + WS_G); LAUNDER(G);
#pragma unroll
                for (int ai = 0; ai < 2; ++ai)
#pragma unroll
                    for (int m = 0; m < 4; ++m) { const size_t row = (size_t)(row0 + ai * 128 + m * 16);
                        f32x4 h0, h1;
#pragma unroll
                        for (int e = 0; e < 4; ++e) { const float r = rs[ai][m]; h0[e] = acc[ai][0][m][0][e] * r * sigmoidf_(acc[ai][1][m][0][e] * r); h1[e] = acc[ai][0][m][1][e] * r * sigmoidf_(acc[ai][1][m][1][e] * r); }
                        *(u32x4*)(G + row * 1024 + pn * 128 + tc) = pack8(h0, h1); }
            } else if (pn < 16) {
                const int t = pn - 8, h = t & 3, mp = wc >> 1, d0 = (wc & 1) * 32 + 8 * fq;
                bf16_t* qk = (bf16_t*)(ws + (t >= 4 ? WS_K : WS_Q)); const float* cosT = (const float*)(ws + WS_COS); const float* sinT = (const float*)(ws + WS_SIN); LAUNDER(qk); LAUNDER(cosT); LAUNDER(sinT);
                bf16_t* dst = qk + h * 256 + mp * 128 + d0;
#pragma unroll
                for (int ai = 0; ai < 2; ++ai)
#pragma unroll
                    for (int m = 0; m < 4; ++m) { const size_t row = (size_t)(row0 + ai * 128 + m * 16);
                        const f32x4 c0 = *(const f32x4*)(cosT + row * 64 + d0), c1 = *(const f32x4*)(cosT + row * 64 + d0 + 4);
                        const f32x4 s0 = *(const f32x4*)(sinT + row * 64 + d0), s1 = *(const f32x4*)(sinT + row * 64 + d0 + 4);
                        const float r = rs[ai][m]; const f32x4 a0 = acc[ai][0][m][0] * r, a1 = acc[ai][0][m][1] * r, b0 = acc[ai][1][m][0] * r, b1 = acc[ai][1][m][1] * r;
                        *(u32x4*)(dst + row * 1024) = pack8(a0 * c0 - b0 * s0, a1 * c1 - b1 * s1);
                        *(u32x4*)(dst + row * 1024 + 64) = pack8(b0 * c0 + a0 * s0, b1 * c1 + a1 * s1); }
            } else if (pn < 20) {
                const int h = pn - 16; bf16_t* Vb = (bf16_t*)(ws + WS_V); LAUNDER(Vb);
#pragma unroll
                for (int ai = 0; ai < 2; ++ai)
#pragma unroll
                    for (int m = 0; m < 4; ++m) { const size_t row = (size_t)(row0 + ai * 128 + m * 16);
#pragma unroll
                        for (int bj = 0; bj < 2; ++bj) *(u32x4*)(Vb + row * 1024 + h * 256 + bj * 128 + tc) = pack8(acc[ai][bj][m][0] * rs[ai][m], acc[ai][bj][m][1] * rs[ai][m]); }
            } else {
                bf16_t* gbase = (bf16_t*)(ws + (pn < 28 ? WS_GC : WS_GA)); LAUNDER(gbase);
                bf16_t* dst = gbase + ((pn - 20) & 7) * 256 + tc;
#pragma unroll
                for (int ai = 0; ai < 2; ++ai)
#pragma unroll
                    for (int m = 0; m < 4; ++m) { const size_t row = (size_t)(row0 + ai * 128 + m * 16);
#pragma unroll
                        for (int bj = 0; bj < 2; ++bj) { f32x4 v0, v1;
#pragma unroll
                            for (int e = 0; e < 4; ++e) { v0[e] = sigmoidf_(acc[ai][bj][m][0][e] * rs[ai][m]); v1[e] = sigmoidf_(acc[ai][bj][m][1][e] * rs[ai][m]); }
                            *(u32x4*)(dst + row * DM + bj * 128) = pack8(v0, v1); } }
            }
        }
    }
};

__device__ __forceinline__ int map_ffn_in(int c) { const int half = c >= DFF ? 1 : 0, j = c - half * DFF; return 256 * (j >> 7) + half * 128 + (j & 127); }
__device__ __forceinline__ int map_mix_in(int c) {
    if (c < 2048) { const int half = c >= 1024 ? 1 : 0, j = c - half * 1024; return 256 * (j >> 7) + half * 128 + (j & 127); }
    if (c < 4096) { const int cc = c - 2048, t = cc >> 8, mp = (cc >> 7) & 1, d = cc & 127; return 2048 + 256 * t + (d >> 6) * 128 + mp * 64 + (d & 63); }
    return c;
}
__device__ __forceinline__ void transpose_item(const float* W, int K, int N, bf16_t* WT, int maptype, const float* gain, LAS float* scr, int item, int lane) {
    const int nblk = N / 32, kb = item / nblk, nb = item % nblk, k0 = 64 * kb, n0 = 32 * nb;
    const int drow = maptype == 1 ? map_ffn_in(n0) : (maptype == 2 ? map_mix_in(n0) : n0);
#pragma unroll 8
    for (int i = 0; i < 32; ++i) { const int kk = 2 * i + (lane >> 5); scr[kk * 33 + (lane & 31)] = W[(size_t)(k0 + kk) * N + n0 + (lane & 31)]; }
    asm volatile("s_waitcnt lgkmcnt(0)" ::: "memory");
    const int c = lane & 7;
    f32x4 g0 = {1.f, 1.f, 1.f, 1.f}, g1 = g0;
    if (gain) { g0 = *(const f32x4*)(gain + k0 + 8 * c); g1 = *(const f32x4*)(gain + k0 + 8 * c + 4); }
#pragma unroll
    for (int j = 0; j < 4; ++j) { const int n = (lane >> 3) + 8 * j; const LAS float* s = scr + (8 * c) * 33 + n;
        u32x4 o; o.x = pkbf(s[0 * 33] * g0[0], s[1 * 33] * g0[1]); o.y = pkbf(s[2 * 33] * g0[2], s[3 * 33] * g0[3]); o.z = pkbf(s[4 * 33] * g1[0], s[5 * 33] * g1[1]); o.w = pkbf(s[6 * 33] * g1[2], s[7 * 33] * g1[3]);
        *(u32x4*)(WT + (size_t)(drow + n) * K + k0 + 8 * c) = o; }
    asm volatile("s_waitcnt lgkmcnt(0)" ::: "memory");
}

__device__ __forceinline__ const void* karg_in(int i) {
    int off = i * 8; asm volatile("" : "+s"(off));
    const char __attribute__((address_space(4)))* k = (const char __attribute__((address_space(4)))*)__builtin_amdgcn_kernarg_segment_ptr();
    return *(const void* const __attribute__((address_space(4)))*)(k + off);
}
struct Params {
    const void* in[26];
    float* out;
    unsigned char* ws;
};

__device__ __forceinline__ void wdesc(int id, int& inp, int& K, int& N, size_t& off, int& mt) {
    switch (id) {
        case 0:  inp = 4;  K = DM;   N = 2 * DFF; off = OW_F1I; mt = 1; break;
        case 1:  inp = 5;  K = DFF;  N = DM;      off = OW_F1O; mt = 0; break;
        case 2:  inp = 7;  K = DM;   N = MIXN;    off = OW_MI;  mt = 2; break;
        case 3:  inp = 12; K = 1024; N = DM;      off = OW_WC;  mt = 0; break;
        case 4:  inp = 15; K = 1024; N = DM;      off = OW_WD;  mt = 0; break;
        case 5:  inp = 16; K = DM;   N = DM;      off = OW_MO;  mt = 0; break;
        case 6:  inp = 19; K = DM;   N = MEMW;    off = OW_CQ;  mt = 0; break;
        case 7:  inp = 20; K = DM;   N = 2 * MEMW; off = OW_CKV; mt = 0; break;
        case 8:  inp = 21; K = MEMW; N = DM;      off = OW_CO;  mt = 0; break;
        case 9:  inp = 23; K = DM;   N = 2 * DFF; off = OW_F2I; mt = 1; break;
        default: inp = 24; K = DFF;  N = DM;      off = OW_F2O; mt = 0; break;
    }
}

__device__ __forceinline__ void phase_prologue(const Params& P, LAS unsigned char* lds, int vcu, int NGW) {
    asm volatile("" : "+s"(NGW));
    const int tid = opaque_tid(), lane = tid & 63, wave = __builtin_amdgcn_readfirstlane(tid >> 6), gw = vcu * 8 + wave;
    LAS float* scr = (LAS float*)(lds + wave * 16384);
    constexpr int ITEMS_PER_LAYER = 49152;
    for (int it = gw; it < DEPTH * ITEMS_PER_LAYER; it += NGW) {
        const int layer = it / ITEMS_PER_LAYER; int r = it - layer * ITEMS_PER_LAYER;
        int id = 0;
        for (;;) { int inp, K, N, mt; size_t off; wdesc(id, inp, K, N, off, mt); const int n_it = (K / 64) * (N / 32);
            if (r < n_it) { const int gi = id == 0 ? 3 : (id == 2 ? 6 : (id == 6 ? 17 : (id == 9 ? 22 : -1)));
                const float* gain = (FUSE_NORM && gi >= 0) ? (const float*)karg_in(gi) + layer * DM : nullptr;
                transpose_item((const float*)karg_in(inp) + (size_t)layer * K * N, K, N, (bf16_t*)(P.ws + WS_W + layer * WS_WLAYER) + off, mt, gain, scr, r, lane); break; }
            r -= n_it; ++id; }
    }
    { const float* xin = (const float*)karg_in(0); bf16_t* XN = (bf16_t*)(P.ws + WS_XN); u64_t* SS = (u64_t*)(P.ws + WS_SS);
      for (int m = gw; m < MROWS; m += NGW) {
          const f32x4* xr = (const f32x4*)(xin + (size_t)m * DM) + lane; u32x2* o = (u32x2*)(XN + (size_t)m * DM) + lane; float s = 0.f;
#pragma unroll
          for (int j = 0; j < 8; ++j) { const f32x4 v = xr[64 * j]; s += (v[0] * v[0] + v[1] * v[1]) + (v[2] * v[2] + v[3] * v[3]); u32x2 w; w.x = pkbf(v[0], v[1]); w.y = pkbf(v[2], v[3]); o[64 * j] = w; }
          s = wave_sum(s); if (lane == 0) SS[m] = (u64_t)((double)s * 4096.0); }
      for (int i = gw * 64 + lane; i < 9 * MROWS; i += NGW * 64) SS[MROWS + i] = 0ull;
      const float* mem = (const float*)karg_in(1);
      for (int m = gw; m < DEPTH * NBATCH * MEML; m += NGW) { const int layer = m / (NBATCH * MEML), r = m % (NBATCH * MEML);
          const float* g = (const float*)karg_in(18) + layer * DM;
          const f32x4* xr = (const f32x4*)(mem + (size_t)r * DM) + lane; u32x2* o = (u32x2*)((bf16_t*)(P.ws + WS_MEMN) + (size_t)m * DM) + lane; f32x4 v[8]; float s = 0.f;
#pragma unroll
          for (int j = 0; j < 8; ++j) { v[j] = xr[64 * j]; s += (v[j][0] * v[j][0] + v[j][1] * v[j][1]) + (v[j][2] * v[j][2] + v[j][3] * v[j][3]); }
          const float rr = 1.0f / sqrtf(wave_sum(s) * (1.0f / DM) + RMS_EPS);
#pragma unroll
          for (int j = 0; j < 8; ++j) { const f32x4 t = v[j] * rr * *(const f32x4*)(g + 4 * lane + 256 * j); u32x2 w; w.x = pkbf(t[0], t[1]); w.y = pkbf(t[2], t[3]); o[64 * j] = w; } }
    }
    const int* pos = (const int*)karg_in(2);
    float* cosT = (float*)(P.ws + WS_COS); float* sinT = (float*)(P.ws + WS_SIN);
    for (int idx = gw * 64 + lane; idx < MROWS * 64; idx += NGW * 64) {
        const int row = idx >> 6, i = idx & 63;
        double inv = 1.0;
        for (int k = 0; k < i; ++k) inv *= 0.8659643233600653;
        const float ang = (float)pos[row] * (float)inv;
        const double rev = (double)ang * 0.15915494309189535;
        const float fr = (float)(rev - __builtin_rint(rev));
        cosT[idx] = __builtin_amdgcn_cosf(fr); sinT[idx] = __builtin_amdgcn_sinf(fr);
    }
}

__device__ __forceinline__ void phase_norm(const float* X, const float* g, bf16_t* XN, int nrows, int vcu, int NGW) {
    asm volatile("" : "+s"(NGW));
    const int tid = opaque_tid(), lane = tid & 63, wave = __builtin_amdgcn_readfirstlane(tid >> 6), gw = vcu * 8 + wave;
    f32x4 gv[8];
#pragma unroll
    for (int j = 0; j < 8; ++j) gv[j] = *(const f32x4*)(g + 4 * lane + 256 * j);
    for (int m = gw; m < nrows; m += NGW) {
        const f32x4* xr = (const f32x4*)(X + (size_t)m * DM) + lane;
        f32x4 v[8]; float s = 0.f;
#pragma unroll
        for (int j = 0; j < 8; ++j) { v[j] = xr[64 * j]; s += (v[j][0] * v[j][0] + v[j][1] * v[j][1]) + (v[j][2] * v[j][2] + v[j][3] * v[j][3]); }
        const float r = 1.0f / sqrtf(wave_sum(s) * (1.0f / DM) + RMS_EPS);
        u32x2* o = (u32x2*)(XN + (size_t)m * DM) + lane;
#pragma unroll
        for (int j = 0; j < 8; ++j) { const f32x4 t = v[j] * r * gv[j]; u32x2 w; w.x = pkbf(t[0], t[1]); w.y = pkbf(t[2], t[3]); o[64 * j] = w; }
    }
}
__device__ __forceinline__ void phase_final_norm(const bf16_t* XB, const float* g, float* out, int vcu, int NGW) {
    asm volatile("" : "+s"(NGW));
    const int tid = opaque_tid(), lane = tid & 63, wave = __builtin_amdgcn_readfirstlane(tid >> 6), gw = vcu * 8 + wave;
    f32x4 gv[8];
#pragma unroll
    for (int j = 0; j < 8; ++j) gv[j] = *(const f32x4*)(g + 4 * lane + 256 * j);
    for (int m = gw; m < MROWS; m += NGW) {
        const u32x2* xr = (const u32x2*)(XB + (size_t)m * DM) + lane;
        f32x4 v[8]; float s = 0.f;
#pragma unroll
        for (int j = 0; j < 8; ++j) { const u32x2 t = xr[64 * j]; v[j] = (f32x4){bflo(t.x), bfhi(t.x), bflo(t.y), bfhi(t.y)}; s += (v[j][0] * v[j][0] + v[j][1] * v[j][1]) + (v[j][2] * v[j][2] + v[j][3] * v[j][3]); }
        const float r = 1.0f / sqrtf(wave_sum(s) * (1.0f / DM) + RMS_EPS);
        f32x4* o = (f32x4*)(out + (size_t)m * DM) + lane;
#pragma unroll
        for (int j = 0; j < 8; ++j) o[64 * j] = v[j] * r * gv[j];
    }
}

#ifndef CONV_CT
#define CONV_CT 16
#endif
__device__ __forceinline__ void phase_conv(const bf16_t* G, const float* cw, const float* cb, const float* lg, const float* lb, bf16_t* YC, LAS unsigned char* lds) {
    constexpr int CT = CONV_CT;
    const int tid = opaque_tid(), lane = tid & 63, wave = tid >> 6;
    typedef float f32x2 __attribute__((ext_vector_type(2)));
    f32x2 w[CONV_K];
#pragma unroll
    for (int j = 0; j < CONV_K; ++j) w[j] = *(const f32x2*)(cw + j * CONV_CH + 2 * tid);
    const f32x2 bias = *(const f32x2*)(cb + 2 * tid), g2 = *(const f32x2*)(lg + 2 * tid), b2 = *(const f32x2*)(lb + 2 * tid);
    LAS float* red = (LAS float*)lds;
    const int tiles_per_wg = (MROWS / CT + (int)gridDim.x - 1) / (int)gridDim.x;
    for (int tile = blockIdx.x * tiles_per_wg; tile < (blockIdx.x + 1) * tiles_per_wg && tile < MROWS / CT; ++tile) {
        const int b = tile / (SEQ / CT), s0 = (tile % (SEQ / CT)) * CT;
        f32x2 acc[CT];
#pragma unroll
        for (int t = 0; t < CT; ++t) acc[t] = bias;
#pragma unroll
        for (int tp = 0; tp < CT + CONV_K - 1; ++tp) {
            const int s = s0 - (CONV_K - 1) + tp;
            f32x2 v = (f32x2){0.f, 0.f};
            { const unsigned raw = *(const unsigned*)(G + (size_t)(b * SEQ + (s < 0 ? 0 : s)) * CONV_CH + 2 * tid);
              if (s >= 0) v = (f32x2){bflo(raw), bfhi(raw)}; }
#pragma unroll
            for (int t = 0; t < CT; ++t) { const int j = tp - t; if (j >= 0 && j < CONV_K) acc[t] += w[j] * v; }
        }
#pragma unroll
        for (int t = 0; t < CT; ++t) {
            const float p1 = wave_sum(acc[t][0] + acc[t][1]);
            const float p2 = wave_sum(acc[t][0] * acc[t][0] + acc[t][1] * acc[t][1]);
            if (lane == 0) { red[wave * 2 * CT + 2 * t] = p1; red[wave * 2 * CT + 2 * t + 1] = p2; }
        }
        __syncthreads();
        if (tid < 2 * CT) { float s = 0.f;
#pragma unroll
            for (int k = 0; k < 8; ++k) s += red[k * 2 * CT + tid];
            red[512 + tid] = s; }
        __syncthreads();
#pragma unroll
        for (int t = 0; t < CT; ++t) {
            const float mean = red[512 + 2 * t] * (1.0f / CONV_CH);
            const float var = red[512 + 2 * t + 1] * (1.0f / CONV_CH) - mean * mean;
            const float r = 1.0f / sqrtf(var + LN_EPS);
            const float y0 = (acc[t][0] - mean) * r * g2[0] + b2[0], y1 = (acc[t][1] - mean) * r * g2[1] + b2[1];
            *(unsigned*)(YC + (size_t)(b * SEQ + s0 + t) * CONV_CH + 2 * tid) = pkbf(siluf_(y0), siluf_(y1));
        }
        __syncthreads();
    }
}

__device__ __forceinline__ void phase_combine(const bf16_t* O, const float* lamp, const float* subg, bf16_t* OC, int layer, int vcu, int NGW) {
    asm volatile("" : "+s"(NGW));
    const int tid = opaque_tid(), lane = tid & 63, wave = __builtin_amdgcn_readfirstlane(tid >> 6), gw = vcu * 8 + wave;
    const float lam_init = layer == 0 ? 0.2f : 0.35550906759096934f;
    const float d1 = wave_sum(lamp[lane] * lamp[128 + lane] + lamp[64 + lane] * lamp[192 + lane]);
    const float d2 = wave_sum(lamp[256 + lane] * lamp[384 + lane] + lamp[320 + lane] * lamp[448 + lane]);
    const float lam = expf(d1) - expf(d2) + lam_init;
    const f32x4 gv = *(const f32x4*)(subg + 4 * lane);
    const float post = 1.0f - lam_init;
    for (int it = gw; it < MROWS * 4; it += NGW) {
        const int row = it >> 2, h = it & 3;
        const bf16_t* src = O + (size_t)row * 2048 + h * 512 + 4 * lane;
        const u32x2 a = *(const u32x2*)src, b = *(const u32x2*)(src + 256);
        f32x4 d;
        d[0] = bflo(a.x) - lam * bflo(b.x); d[1] = bfhi(a.x) - lam * bfhi(b.x); d[2] = bflo(a.y) - lam * bflo(b.y); d[3] = bfhi(a.y) - lam * bfhi(b.y);
        const float ss = wave_sum((d[0] * d[0] + d[1] * d[1]) + (d[2] * d[2] + d[3] * d[3]));
        const float r = post / sqrtf(ss * (1.0f / 256.0f) + RMS_EPS);
        const f32x4 o = d * r * gv;
        u32x2 wv; wv.x = pkbf(o[0], o[1]); wv.y = pkbf(o[2], o[3]);
        *(u32x2*)(OC + (size_t)row * 1024 + h * 256 + 4 * lane) = wv;
    }
}

typedef attn::BlockRef<attn::bf16, attn::bf16> ARef;
__device__ __forceinline__ ARef diff_ref(int L, int pass, unsigned char* ws) {
    const int bhs = L >> 4, b = bhs >> 4, sub = bhs & 15, h = sub >> 2, mp = (sub >> 1) & 1, vh = sub & 1, x = L & 15, qb = pass ? x : 31 - x;
    ARef r;
    r.Q = (const attn::bf16*)((const bf16_t*)(ws + WS_Q) + (size_t)(b * SEQ + qb * 256) * 1024 + h * 256 + mp * 128);
    r.K = (const attn::bf16*)((const bf16_t*)(ws + WS_K) + (size_t)(b * SEQ) * 1024 + h * 256 + mp * 128);
    r.V = (const attn::bf16*)((const bf16_t*)(ws + WS_V) + (size_t)(b * SEQ) * 1024 + h * 256 + vh * 128);
    r.O = (attn::bf16*)((bf16_t*)(ws + WS_X) + (size_t)(b * SEQ + qb * 256) * 2048 + h * 512 + mp * 256 + vh * 128);
    r.P0 = qb * 256;
    return r;
}
__device__ __forceinline__ ARef cross_ref(int u, unsigned char* ws) {
    const int b = u >> 7, h = (u >> 5) & 3, qb = u & 31;
    ARef r;
    r.Q = (const attn::bf16*)((const bf16_t*)(ws + WS_CQ) + (size_t)(b * SEQ + qb * 256) * MEMW + h * 128);
    r.K = (const attn::bf16*)((const bf16_t*)(ws + WS_MEMKV) + (size_t)(b * MEML) * 1024 + h * 128);
    r.V = (const attn::bf16*)((const bf16_t*)(ws + WS_MEMKV) + (size_t)(b * MEML) * 1024 + 512 + h * 128);
    r.O = (attn::bf16*)((bf16_t*)(ws + WS_CO) + (size_t)(b * SEQ + qb * 256) * MEMW + h * 128);
    r.P0 = 256;
    return r;
}
template <int KIND>
__device__ __forceinline__ void phase_attn(unsigned char* ws, char* lds, int vcu, int G) {
    constexpr int total = KIND == 0 ? 512 : 256, skv = KIND == 0 ? SEQ : MEML, W = KIND == 0 ? SEQ : (1 << 20);
    typedef attn::AttnLd<(KIND == 0 ? 1024 : MEMW), 1024, (KIND == 0 ? 2048 : MEMW)> LDT;
    const LDT LD{};
    int L = vcu; if (L >= total) return;
    int pass = 0;
    ARef cur = KIND == 0 ? diff_ref(L, 0, ws) : cross_ref(L, ws);
    attn::Seam<attn::bf16> S;
    attn::causal_swa_prime<attn::bf16, attn::bf16, LDT>(cur, W, lds, S, LD);
    for (;;) {
        const bool more_pass = (KIND == 0) && pass == 0, more_item = L + G < total, last = !more_pass && !more_item;
        int passn = pass + 1, Ln = L;
        if (!more_pass) { passn = 0; Ln = more_item ? L + G : L; }
        const ARef nxt = last ? cur : (KIND == 0 ? diff_ref(Ln, passn, ws) : cross_ref(Ln, ws));
        attn::causal_swa_block<attn::bf16, attn::bf16, LDT>(cur, nxt, skv, W, lds, S, LD);
        if (last) break;
        cur = nxt; pass = passn; L = Ln;
    }
}

#ifndef PROBE_STAGE
#define PROBE_STAGE -2
#define PROBE_REP 1
#endif
constexpr int PR_S = PROBE_STAGE, PR_R = PROBE_REP;
constexpr int LAYER_PH = (FUSE_NORM ? 12 : 16) + (PR_S >= 0 ? PR_R : 0), PRO_PH = 1 + (PR_S == -1 ? PR_R : 0);
constexpr int NPHASE = PRO_PH + LAYER_PH * DEPTH + 1;
__global__ void __launch_bounds__(512, 2) mega_fwd(Params P, int ph_lo, int ph_hi) {
    extern __shared__ __attribute__((aligned(16))) unsigned char lds_raw[];
    LAS unsigned char* lds = (LAS unsigned char*)lds_raw;
    cg::grid_group grid = cg::this_grid();
    const int G = gridDim.x, bx = blockIdx.x;
    const int vcu = (G % 8 == 0) ? (bx % 8) * (G / 8) + bx / 8 : bx;
    const int NGW = G * 8;

    volatile LAS unsigned* MISC = (volatile LAS unsigned*)(lds + 131072 + 320);
    { unsigned char* ws = P.ws;
    if (opaque_tid() < 32) MISC[opaque_tid()] = 0u;
    __syncthreads();
    if (ph_hi - ph_lo > 1) { (void)xcd_barrier_post((unsigned*)(ws + WS_CTL), MISC + 8); if (ph_lo < 0) grid.sync(); } }
    for (int ph = ph_lo; ph < ph_hi; ++ph) {
        unsigned char* ws = P.ws; LAUNDER_G(ws);
        float* X = (float*)(ws + WS_X); bf16_t* XN = (bf16_t*)(ws + WS_XN); bf16_t* HID = (bf16_t*)(ws + WS_HID);
        int layer = 0, stage = -1; bool dup = false;
        if (ph == NPHASE - 1) { stage = 16; layer = DEPTH; }
        else if (ph >= PRO_PH) { layer = (ph - PRO_PH) / LAYER_PH; const int q = (ph - PRO_PH) % LAYER_PH;
            int qs;
            if (PR_S < 0 || q < PR_S) qs = q; else if (q <= PR_S + PR_R) { qs = PR_S; dup = q < PR_S + PR_R; } else qs = q - PR_R;
            stage = FUSE_NORM ? qs + 1 + (qs >= 2 ? 1 : 0) + (qs >= 7 ? 1 : 0) + (qs >= 10 ? 1 : 0) : qs; }
        const bf16_t* WL = (const bf16_t*)(ws + WS_W + (size_t)layer * WS_WLAYER);
        const float* xcur = (layer == 0 && stage <= 2) ? (const float*)karg_in(0) : X;
        int ngemm = 0;
        if (stage == -1) {
#ifndef SKIP_PRO
            phase_prologue(P, lds, vcu, NGW);
#endif
        } else if (stage == 16) {
            phase_final_norm(XN, (const float*)karg_in(25), P.out, vcu, NGW);
        } else if (!FUSE_NORM && (stage == 0 || stage == 3 || stage == 9 || stage == 13)) {
            const int gi = stage == 0 ? 3 : (stage == 3 ? 6 : (stage == 9 ? 17 : 22));
            phase_norm(xcur, (const float*)karg_in(gi) + layer * DM, XN, MROWS, vcu, NGW);
        } else if (stage == 5) {
#ifndef SKIP_CONV
            phase_conv((const bf16_t*)(ws + WS_G), (const float*)karg_in(8) + layer * CONV_K * CONV_CH, (const float*)karg_in(9) + layer * CONV_CH,
                       (const float*)karg_in(10) + layer * CONV_CH, (const float*)karg_in(11) + layer * CONV_CH, (bf16_t*)(ws + WS_YC), lds);
#endif
#if !defined(SKIP_ATTN) && !defined(SKIP_ATTN0)
            phase_attn<0>(ws, (char*)lds_raw, vcu, G);
#endif
        } else if (stage == 6) {
            phase_combine((const bf16_t*)(ws + WS_X), (const float*)karg_in(13) + layer * 512, (const float*)karg_in(14) + layer * 256, (bf16_t*)(ws + WS_OC), layer, vcu, NGW);
        } else if (stage == 11) {
#if !defined(SKIP_ATTN) && !defined(SKIP_ATTN1)
            phase_attn<1>(ws, (char*)lds_raw, vcu, G);
#endif
        } else {
            ngemm = (stage == 7 || stage == 10) ? 2 : 1;
        }
        for (int pass = 0; pass < ngemm; ++pass) {
            pg8::Gemm g; Epi E; int cblk = bx;
            E.mode = EPI_BF16; E.perm = 1; E.ldc = 0; E.scale2 = 2; E.o16 = 0; E.gate16 = 0; E.ss16 = 0; E.base_in = 0; E.ws = ws;
            constexpr int SS16 = (int)(WS_SS >> 16);
            g.M = MROWS;
            if (stage == 1 || stage == 14) { g.A = XN; g.Bt = WL + (stage == 1 ? OW_F1I : OW_F2I); g.N = 2 * DFF; g.K = DM; E.mode = EPI_SWIGLU; E.o16 = (int)(WS_HID >> 16); E.ldc = DFF; E.ss16 = FUSE_NORM ? SS16 + 2 * (stage == 1 ? 4 * layer : 3 + 4 * layer) : 0; }
            else if (stage == 2 || stage == 15) { g.A = HID; g.Bt = WL + (stage == 2 ? OW_F1O : OW_F2O); g.N = DM; g.K = DFF; E.mode = EPI_RESID; E.perm = 0; E.base_in = (layer == 0 && stage == 2) ? 1 : 0; E.scale2 = dup ? 0 : 1; E.ss16 = SS16 + 2 * (dup ? 9 : (stage == 2 ? 1 + 4 * layer : 4 + 4 * layer)); }
            else if (stage == 4) { g.A = XN; g.Bt = WL + OW_MI; g.N = MIXN; g.K = DM; E.mode = EPI_MIXIN; E.ss16 = FUSE_NORM ? SS16 + 2 * (1 + 4 * layer) : 0; }
            else if (stage == 7) { g.A = pass == 0 ? (const bf16_t*)(ws + WS_YC) : (const bf16_t*)(ws + WS_OC); g.Bt = WL + (pass == 0 ? OW_WC : OW_WD); g.N = DM; g.K = 1024;
                                   E.mode = pass == 0 ? EPI_MERGE_A : EPI_MERGE_B; E.gate16 = (int)((pass == 0 ? WS_GC : WS_GA) >> 16); E.o16 = (int)(WS_MERGED >> 16); E.ldc = DM; }
            else if (stage == 8) { g.A = (const bf16_t*)(ws + WS_MERGED); g.Bt = WL + OW_MO; g.N = DM; g.K = DM; E.mode = EPI_RESID; E.perm = 0; E.scale2 = dup ? 0 : 2; E.ss16 = SS16 + 2 * (dup ? 9 : 2 + 4 * layer); }
            else if (stage == 10) {
                if (pass == 0) { g.A = XN; g.Bt = WL + OW_CQ; g.N = MEMW; g.K = DM; E.o16 = (int)(WS_CQ >> 16); E.ldc = MEMW; E.ss16 = FUSE_NORM ? SS16 + 2 * (2 + 4 * layer) : 0; }
                else { g.A = (const bf16_t*)(ws + WS_MEMN) + (size_t)layer * NBATCH * MEML * DM; g.Bt = WL + OW_CKV; g.M = NBATCH * MEML; g.N = 2 * MEMW; g.K = DM; E.o16 = (int)(WS_MEMKV >> 16); E.ldc = 2 * MEMW; cblk = (bx + G - 128) % G; }
            }
            else { g.A = (const bf16_t*)(ws + WS_CO); g.Bt = WL + OW_CO; g.N = DM; g.K = MEMW; E.mode = EPI_RESID; E.perm = 0; E.scale2 = dup ? 0 : 2; E.ss16 = SS16 + 2 * (dup ? 9 : 3 + 4 * layer); }
            pg8::StaticOrder S; S.init(g.M, g.N, G, cblk);
#ifndef SKIP_GEMM
            pg8::gemm_phase<Epi, pg8::StaticOrder, true, true>(lds, g, S, E);
#endif
        }
        if (ph + 1 < ph_hi) {
            XcdBarrier bar; bar.bar = (unsigned*)(ws + WS_CTL); bar.x = xb_xcc_id(); bar.st = (volatile LAS unsigned*)(lds + 131072 + 320) + 8;
            xcd_barrier(bar);
        }
    }
}

extern "C" void kernel_launch(void* const* d_in, const int* in_sizes, int n_in, void* d_out, int out_size, void* d_ws, size_t ws_size, hipStream_t stream) {
    static int grid = 0;
    if (grid == 0) {
        if (n_in != 26 || out_size != MROWS * DM || ws_size < WS_END) { fprintf(stderr, "kernel_launch: unexpected shapes (n_in %d out %d ws %zu, need ws >= %zu); nothing launched\n", n_in, out_size, ws_size, (size_t)WS_END); grid = -1; return; }
        int dev = 0, cus = 0, per_cu = 0;
        (void)hipGetDevice(&dev);
        if (hipDeviceGetAttribute(&cus, hipDeviceAttributeMultiprocessorCount, dev) != hipSuccess || cus <= 0) cus = 256;
        if (hipFuncSetAttribute((const void*)mega_fwd, hipFuncAttributeMaxDynamicSharedMemorySize, LDS_BYTES) != hipSuccess) fprintf(stderr, "kernel_launch: hipFuncSetAttribute failed\n");
        if (hipOccupancyMaxActiveBlocksPerMultiprocessor(&per_cu, (const void*)mega_fwd, 512, LDS_BYTES) != hipSuccess || per_cu < 1) { fprintf(stderr, "kernel_launch: occupancy query says %d\n", per_cu); per_cu = 1; }
        (void)hipGetLastError();
        grid = cus * (per_cu > 1 ? 1 : per_cu);
    }
    if (grid < 0) return;
    if (hipMemsetAsync((char*)d_ws + WS_CTL, 0, CTL_ZERO_BYTES, stream) != hipSuccess) { fprintf(stderr, "kernel_launch: memset of the control words failed\n"); return; }
    Params p{};
    for (int i = 0; i < 26; ++i) p.in[i] = d_in[i];
    p.out = (float*)d_out; p.ws = (unsigned char*)d_ws;
#if MK_PER_PHASE
    for (int ph = 0; ph < NPHASE; ++ph) hipLaunchKernelGGL(mega_fwd, dim3(grid), dim3(512), LDS_BYTES, stream, p, ph, ph + 1);
#else
    int lo = 0, hi = NPHASE;
    void* args[] = {(void*)&p, (void*)&lo, (void*)&hi};
    hipError_t e = hipLaunchCooperativeKernel((const void*)mega_fwd, dim3(grid), dim3(512), args, LDS_BYTES, stream);
    if (e != hipSuccess) fprintf(stderr, "kernel_launch: cooperative launch failed: %s (grid %d)\n", hipGetErrorString(e), grid);
#endif
}
```

```cpp
#include <hip/hip_runtime.h>
#include <hip/hip_bf16.h>
#include <hip/hip_cooperative_groups.h>
#include <cstdio>
#include <cstdint>
namespace cg = cooperative_groups;

#ifndef MK_PER_PHASE
#define MK_PER_PHASE 0
#endif

constexpr int DM = 2048, NBATCH = 2, SEQ = 8192, MROWS = NBATCH * SEQ, DEPTH = 2;
constexpr int CONV_CH = 1024, CONV_K = 31, MIXN = 9216, MEML = 256, MEMW = 512, DFF = 5632;
constexpr float RMS_EPS = 1e-6f, LN_EPS = 1e-5f;

constexpr size_t MiB = (size_t)1 << 20;
constexpr size_t WS_W = 0, WS_WLAYER = 192 * MiB;
constexpr size_t OW_F1I = 0, OW_F1O = 23068672, OW_MI = 34603008, OW_WC = 53477376, OW_WD = 55574528, OW_MO = 57671680,
                 OW_CQ = 61865984, OW_CKV = 62914560, OW_CO = 65011712, OW_F2I = 66060288, OW_F2O = 89128960;
constexpr size_t WS_X = 384 * MiB;
constexpr size_t WS_XN = 512 * MiB;
constexpr size_t WS_BIG = 576 * MiB;
constexpr size_t WS_G = WS_BIG, WS_K = WS_BIG + 32 * MiB, WS_Q = WS_BIG + 64 * MiB, WS_V = WS_BIG + 96 * MiB, WS_GC = WS_BIG + 128 * MiB, WS_GA = WS_BIG + 192 * MiB;
constexpr size_t WS_HID = WS_BIG, WS_MERGED = WS_BIG, WS_OC = WS_Q, WS_CQ = WS_V, WS_CO = WS_V + 16 * MiB;
constexpr size_t WS_YC = 832 * MiB;
constexpr size_t WS_COS = 864 * MiB, WS_SIN = 868 * MiB;
constexpr size_t WS_MEMN = 872 * MiB, WS_MEMKV = 876 * MiB;
constexpr size_t WS_CTL = 877 * MiB;
constexpr size_t WS_SS = WS_CTL + 65536;
constexpr size_t CTL_ZERO_BYTES = 65536;
constexpr size_t WS_END = 879 * MiB;

constexpr int LDS_BYTES = 147456;

typedef unsigned short bf16_t;

__device__ __forceinline__ int opaque_tid() { int t = threadIdx.x; asm volatile("" : "+v"(t)); return t; }

template <int CTRL> __device__ __forceinline__ float dpp_mov(float v) { const int i = __builtin_bit_cast(int, v); return __builtin_bit_cast(float, __builtin_amdgcn_update_dpp(i, i, CTRL, 0xf, 0xf, true)); }
__device__ __forceinline__ float lane_xor1(float v) { return dpp_mov<0xB1>(v); }
__device__ __forceinline__ float wave_sum(float v) {
    v += dpp_mov<0xB1>(v); v += dpp_mov<0x4E>(v); v += dpp_mov<0x141>(v); v += dpp_mov<0x140>(v);
    { auto rr = __builtin_amdgcn_permlane16_swap(__float_as_uint(v), __float_as_uint(v), false, false); v = __uint_as_float(rr[0]) + __uint_as_float(rr[1]); }
    { auto rr = __builtin_amdgcn_permlane32_swap(__float_as_uint(v), __float_as_uint(v), false, false); v = __uint_as_float(rr[0]) + __uint_as_float(rr[1]); }
    return v;
}

#ifndef FUSE_NORM
#define FUSE_NORM 1
#endif

typedef __attribute__((address_space(1))) unsigned char* gptr_t;
#define LAUNDER_G(p) do { gptr_t g_ = (gptr_t)(p); asm volatile("" : "+s"(g_)); (p) = (decltype(p))g_; } while (0)

namespace pg8 {
#define PG8_LAS __attribute__((address_space(3)))
typedef unsigned short bf16_t;
typedef short bf16x8 __attribute__((ext_vector_type(8)));
typedef float f32x4 __attribute__((ext_vector_type(4)));
typedef unsigned u32x4 __attribute__((ext_vector_type(4)));
constexpr int BM = 256, BK = 64, HALF = 128, HTB = HALF * BK * 2  , STAGE_BYTES = 8 * HTB, NXCD = 8, WGM = 8;

__host__ __device__ __forceinline__ int lds_byte(int r, int c) { const int st = (r >> 4) * 2 + (c >> 5), rr = r & 15, cc = c & 31, ob = rr * 64 + cc * 2; return st * 1024 + (ob ^ (((ob >> 9) & 1) << 5)); }
__host__ __device__ __forceinline__ void stage_rc(int b, int& R, int& C) { const int st = b / 1024, sb = b % 1024, swz = sb ^ (((sb >> 9) & 1) << 5); R = (st >> 1) * 16 + swz / 64; C = (st & 1) * 32 + (swz % 64) / 2; }
__host__ __device__ __forceinline__ int perm32(int rho) { const int n = rho >> 4, i = rho & 15; return 8 * (i >> 2) + 4 * n + (i & 3); }

struct Unit { int pm, pn; };
struct Gemm { const bf16_t* A; const bf16_t* Bt; int M, N, K; };

struct StaticOrder {
    int nM, nN, nwg, G, c;
    __host__ __device__ void init(int M, int N, int G_, int c_) { nM = M / BM; nN = N / BM; nwg = nM * nN; G = G_; c = c_; }
    __host__ __device__ bool next(int i, Unit& u) const {
        const long L = (long)i * G + c; if (L >= nwg) return false;
        int wgid = (int)L; { const int q = nwg / NXCD, r = nwg % NXCD, xcd = wgid % NXCD, off = wgid / NXCD; wgid = (xcd < r ? xcd * (q + 1) : r * (q + 1) + (xcd - r) * q) + off; }
        const int nig = WGM * nN, gid = wgid / nig, fm = gid * WGM, gsz = (nM - fm) < WGM ? (nM - fm) : WGM;
        u.pm = fm + ((wgid % nig) % gsz); u.pn = (wgid % nig) / gsz; return true;
    }
    __device__ __forceinline__ void a_ready(const Unit&) const {}
    __device__ __forceinline__ void done(const Unit&) const {}
};
__device__ __forceinline__ unsigned cvt_pk_bf16(float lo, float hi) { unsigned r; asm volatile("v_cvt_pk_bf16_f32 %0, %1, %2" : "=v"(r) : "v"(lo), "v"(hi)); return r; }
template <class Epi, class Sched, bool ALIGN_EPI = false, bool SP2 = false>
__device__ __forceinline__ void gemm_phase(PG8_LAS unsigned char* lds, const Gemm g, const Sched& S, const Epi& E) {
    const int tid = opaque_tid(), wid = __builtin_amdgcn_readfirstlane(tid >> 6), lane = tid & 63, wr = wid >> 2, wc = wid & 3, fr = lane & 15, fq = lane >> 4;
    const int K = g.K, nt = K / BK;
    unsigned voffA[2], voffB[2];
#pragma unroll
    for (int i = 0; i < 2; ++i) { int R, C; stage_rc(tid * 16 + i * 8192, R, C); const int Rb = E.perm ? ((R & ~31) + perm32(R & 31)) : R;
        voffA[i] = (unsigned)(R * K + C) * 2u; voffB[i] = (unsigned)(Rb * K + C) * 2u; }
    const size_t kstep = (size_t)(BK * 2);
    const size_t hstep = (size_t)HALF * K * 2;
    const size_t tstep = 2 * hstep;
    const unsigned ldsw = (unsigned)wid * 1024u;
    const int aoff = lds_byte(wr * 64 + fr, fq * 8), boff = lds_byte(wc * 32 + fr, fq * 8);
#define PG8_SA(b, h) (((b) * 2 + (h)) * HTB)
#define PG8_SB(b, h) ((4 + (b) * 2 + (h)) * HTB)
#define PG8_STAGE(bufoff, gbase, voff) do { _Pragma("unroll") for (int _i = 0; _i < 2; ++_i) \
        __builtin_amdgcn_global_load_lds((const unsigned*)((const char*)(gbase) + (voff)[_i]), (PG8_LAS unsigned*)(lds + (bufoff) + ldsw + _i * 8192), 16, 0, 0); } while (0)
#define PG8_LDA(dst, b, h) do { _Pragma("unroll") for (int m = 0; m < 4; ++m) _Pragma("unroll") for (int k = 0; k < 2; ++k) dst[m][k] = *(const PG8_LAS bf16x8*)(lds + PG8_SA(b, h) + aoff + m * 2048 + k * 1024); } while (0)
#define PG8_LDB(dst, b, h) do { _Pragma("unroll") for (int n = 0; n < 2; ++n) _Pragma("unroll") for (int k = 0; k < 2; ++k) dst[n][k] = *(const PG8_LAS bf16x8*)(lds + PG8_SB(b, h) + boff + n * 2048 + k * 1024); } while (0)
#define PG8_MMA(ai, bj, At, Bt) do { __builtin_amdgcn_s_setprio(1); _Pragma("unroll") for (int m = 0; m < 4; ++m) _Pragma("unroll") for (int n = 0; n < 2; ++n) _Pragma("unroll") for (int k = 0; k < 2; ++k) \
        acc[ai][bj][m][n] = __builtin_amdgcn_mfma_f32_16x16x32_bf16(Bt[n][k], At[m][k], acc[ai][bj][m][n], 0, 0, 0); __builtin_amdgcn_s_setprio(0); } while (0)
#define PG8_WAIT_V(n) asm volatile("s_waitcnt vmcnt(" #n ")" ::: "memory")
#define PG8_WAIT_L(n) asm volatile("s_waitcnt lgkmcnt(" #n ")" ::: "memory")
#define PG8_BAR __builtin_amdgcn_s_barrier()
#define PG8_SCHED __builtin_amdgcn_sched_barrier(0)
    Unit cur, nxt; int ui = 0;
    if (!S.next(0, cur)) return;
    f32x4 acc[2][2][4][2];
#pragma unroll
    for (int a = 0; a < 2; ++a)
#pragma unroll
        for (int b = 0; b < 2; ++b)
#pragma unroll
            for (int m = 0; m < 4; ++m)
#pragma unroll
                for (int n = 0; n < 2; ++n) acc[a][b][m][n] = (f32x4){0.f, 0.f, 0.f, 0.f};
    bf16x8 At[4][2], B0[2][2], B1[2][2];
    const char* cA = (const char*)g.A + (size_t)cur.pm * tstep; const char* cB = (const char*)g.Bt + (size_t)cur.pn * tstep;
    unsigned long long ssv[8]; E.pre(ssv, cur, wr, fr);
    S.a_ready(cur);
    if constexpr (SP2) {
        PG8_STAGE(PG8_SB(0, 0), cB, voffB); PG8_STAGE(PG8_SB(0, 1), cB + hstep, voffB); PG8_STAGE(PG8_SA(0, 0), cA, voffA); PG8_STAGE(PG8_SA(0, 1), cA + hstep, voffA);
        if (wr == 1) PG8_BAR;
        PG8_WAIT_V(2); PG8_BAR;
        PG8_STAGE(PG8_SB(1, 0), cB + kstep, voffB); PG8_STAGE(PG8_SA(1, 0), cA + kstep, voffA); PG8_STAGE(PG8_SB(1, 1), cB + hstep + kstep, voffB);
        PG8_WAIT_V(6); PG8_BAR;
    } else {
        PG8_STAGE(PG8_SB(0, 0), cB, voffB); PG8_STAGE(PG8_SA(0, 0), cA, voffA); PG8_STAGE(PG8_SB(0, 1), cB + hstep, voffB); PG8_STAGE(PG8_SA(0, 1), cA + hstep, voffA);
        if (wr == 1) PG8_BAR;
        PG8_WAIT_V(4); PG8_BAR;
        PG8_STAGE(PG8_SB(1, 0), cB + kstep, voffB); PG8_STAGE(PG8_SA(1, 0), cA + kstep, voffA); PG8_STAGE(PG8_SB(1, 1), cB + hstep + kstep, voffB);
        PG8_WAIT_V(6); PG8_BAR;
    }
    for (;;) {
        const bool has_next = S.next(ui + 1, nxt);
        const char* nA = has_next ? (const char*)g.A + (size_t)nxt.pm * tstep : cA; const char* nB = has_next ? (const char*)g.Bt + (size_t)nxt.pn * tstep : cB;
        for (int t = 0; t < nt; t += 2) {
            const bool last = (t == nt - 2);
            const char* a1 = cA + (size_t)(t + 1) * kstep;
            const char* a2 = last ? nA : cA + (size_t)(t + 2) * kstep; const char* b2 = last ? nB : cB + (size_t)(t + 2) * kstep;
            const char* a3 = a2 + kstep; const char* b3 = b2 + kstep;
            if (last && has_next) S.a_ready(nxt);
            if constexpr (SP2) {
            PG8_LDB(B0, 0, 0); PG8_LDB(B1, 0, 1); PG8_SCHED; PG8_LDA(At, 0, 0); PG8_STAGE(PG8_SA(1, 1), a1 + hstep, voffA);
            PG8_WAIT_V(8); PG8_WAIT_L(0); PG8_BAR; PG8_MMA(0, 0, At, B0); PG8_MMA(0, 1, At, B1); PG8_BAR; PG8_SCHED;
            PG8_LDA(At, 0, 1); PG8_STAGE(PG8_SB(0, 0), b2, voffB); PG8_STAGE(PG8_SB(0, 1), b2 + hstep, voffB); PG8_STAGE(PG8_SA(0, 0), a2, voffA);
            PG8_WAIT_V(8); PG8_WAIT_L(0); PG8_BAR; PG8_MMA(1, 0, At, B0); PG8_MMA(1, 1, At, B1); PG8_BAR; PG8_SCHED;
            PG8_LDB(B0, 1, 0); PG8_LDB(B1, 1, 1); PG8_SCHED; PG8_LDA(At, 1, 0); PG8_STAGE(PG8_SA(0, 1), a2 + hstep, voffA);
            PG8_WAIT_V(8); PG8_WAIT_L(0); PG8_BAR; PG8_MMA(0, 0, At, B0); PG8_MMA(0, 1, At, B1); PG8_BAR; PG8_SCHED;
            PG8_LDA(At, 1, 1); PG8_STAGE(PG8_SB(1, 0), b3, voffB); PG8_STAGE(PG8_SB(1, 1), b3 + hstep, voffB); PG8_STAGE(PG8_SA(1, 0), a3, voffA);
            PG8_WAIT_V(8); PG8_WAIT_L(0); PG8_BAR; PG8_MMA(1, 0, At, B0); PG8_MMA(1, 1, At, B1); PG8_BAR; PG8_SCHED;
            } else {
            PG8_LDB(B0, 0, 0); PG8_SCHED; PG8_LDA(At, 0, 0); PG8_STAGE(PG8_SA(1, 1), a1 + hstep, voffA);
            PG8_WAIT_L(8); PG8_BAR; PG8_WAIT_L(0); PG8_MMA(0, 0, At, B0); PG8_BAR; PG8_SCHED;
            PG8_LDB(B1, 0, 1); PG8_STAGE(PG8_SB(0, 0), b2, voffB);
            PG8_BAR; PG8_WAIT_L(0); PG8_MMA(0, 1, At, B1); PG8_BAR;
            PG8_LDA(At, 0, 1); PG8_STAGE(PG8_SA(0, 0), a2, voffA);
            PG8_BAR; PG8_WAIT_L(0); PG8_MMA(1, 0, At, B0); PG8_BAR; PG8_SCHED;
            PG8_STAGE(PG8_SB(0, 1), b2 + hstep, voffB);
            PG8_WAIT_V(6); PG8_BAR; PG8_MMA(1, 1, At, B1); PG8_BAR;
            PG8_LDB(B0, 1, 0); PG8_SCHED; PG8_LDA(At, 1, 0); PG8_STAGE(PG8_SA(0, 1), a2 + hstep, voffA);
            PG8_WAIT_L(8); PG8_BAR; PG8_WAIT_L(0); PG8_MMA(0, 0, At, B0); PG8_BAR; PG8_SCHED;
            PG8_LDB(B1, 1, 1); PG8_STAGE(PG8_SB(1, 0), b3, voffB);
            PG8_BAR; PG8_WAIT_L(0); PG8_MMA(0, 1, At, B1); PG8_BAR;
            PG8_LDA(At, 1, 1); PG8_STAGE(PG8_SA(1, 0), a3, voffA);
            PG8_BAR; PG8_WAIT_L(0); PG8_MMA(1, 0, At, B0); PG8_BAR; PG8_SCHED;
            PG8_STAGE(PG8_SB(1, 1), b3 + hstep, voffB);
            PG8_WAIT_V(6); PG8_BAR; PG8_MMA(1, 1, At, B1); PG8_BAR;
            }
        }
        if constexpr (ALIGN_EPI) { if (wr == 0) PG8_BAR; }
        E(acc, cur, wr, wc, fr, fq, ssv);
        if (!has_next) break;
#pragma unroll
        for (int a = 0; a < 2; ++a)
#pragma unroll
            for (int b = 0; b < 2; ++b)
#pragma unroll
                for (int m = 0; m < 4; ++m)
#pragma unroll
                    for (int n = 0; n < 2; ++n) acc[a][b][m][n] = (f32x4){0.f, 0.f, 0.f, 0.f};
        cur = nxt; cA = nA; cB = nB; ++ui;
        E.pre(ssv, cur, wr, fr);
        if constexpr (ALIGN_EPI) { if (wr == 1) PG8_BAR; }
    }
    PG8_WAIT_V(0);
    if constexpr (!ALIGN_EPI) { if (wr == 0) PG8_BAR; }
    PG8_BAR;

#undef PG8_SA
#undef PG8_SB
#undef PG8_STAGE
#undef PG8_LDA
#undef PG8_LDB
#undef PG8_MMA
#undef PG8_WAIT_V
#undef PG8_WAIT_L
#undef PG8_BAR
#undef PG8_SCHED
}
}

namespace attn {
constexpr int D = 128; constexpr float THR = 8.f; constexpr bool WSKIP = false;
template <int LQ, int LKV, int LO> struct AttnLd { static constexpr int q = LQ, kv = LKV, o = LO; };
constexpr float SCALE = 0.08838834764831845f;
constexpr int NW = 8, QBLK = 32, KVBLK = 64, QB = NW * QBLK;
constexpr int SHM_V = KVBLK * D * 2, SHM_K = KVBLK * D * 2;
constexpr int LDS_BYTES = 2 * SHM_V + 2 * SHM_K + NW * 64 * 4;

using bf16 = __hip_bfloat16;
typedef short bf16x8 __attribute__((ext_vector_type(8)));
typedef short s16x4 __attribute__((ext_vector_type(4)));
typedef float f32x16 __attribute__((ext_vector_type(16)));
typedef float f32x4 __attribute__((ext_vector_type(4)));
typedef unsigned u32x4 __attribute__((ext_vector_type(4)));
template <class A, class Bt> struct same_t { static constexpr bool v = false; };
template <class A> struct same_t<A, A> { static constexpr bool v = true; };

#define KSWZ(row, colB) ((row) * 256 + ((colB) ^ (((row) & 7) << 4)))
#define SBAR() __builtin_amdgcn_sched_barrier(0)
__device__ __forceinline__ int v_st(int k, int c) { const int kk = (k & ~0xC) | ((k & 4) << 1) | ((k & 8) >> 1); return ((kk >> 3) * 4 + (c >> 5)) * 512 + ((kk & 7) * 32 + (c & 31)) * 2; }
__device__ __forceinline__ int v_rd_base(int lane) { return ((lane & 3) << 3) | (((lane >> 2) & 3) << 6) | (((lane >> 4) & 1) << 5) | (((lane >> 5) & 1) << 8); }
constexpr int v_rd_off(int d0, int ks, int half) { return d0 * 512 + ks * 4096 + half * 2048; }
__device__ __forceinline__ int crow(int r, int hi) { return (r & 3) + 8 * (r >> 2) + 4 * hi; }
__device__ __forceinline__ unsigned cvtpk(float lo, float hi) {
    unsigned r; asm volatile("v_cvt_pk_bf16_f32 %0, %1, %2" : "=v"(r) : "v"(lo), "v"(hi)); return r;
}
__device__ __forceinline__ bf16x8 pack8(f32x4 a, f32x4 b) {
    u32x4 w = {cvtpk(a[0], a[1]), cvtpk(a[2], a[3]), cvtpk(b[0], b[1]), cvtpk(b[2], b[3])};
    return *reinterpret_cast<bf16x8*>(&w);
}
template <class T> __device__ __forceinline__ bf16x8 load8(const T* p) {
    if constexpr (same_t<T, float>::v) { return pack8(*(const f32x4*)p, *(const f32x4*)(p + 4)); }
    else { return *reinterpret_cast<const bf16x8*>(p); }
}
__device__ __forceinline__ void mask_tile(f32x16& p0, f32x16& p1, int dq, unsigned W) {
    const float NEG = -__builtin_inff();
#pragma unroll
    for (int r = 0; r < 16; ++r) {
        const int c = (r & 3) + 8 * (r >> 2);
        if ((unsigned)(dq - c) >= W) p0[r] = NEG;
        if ((unsigned)(dq - c - 32) >= W) p1[r] = NEG;
    }
}
__device__ __forceinline__ void partialSM(f32x16& p0, f32x16& p1, float& m_reg, float& mn, float& alpha) {
    float pmax = p0[0]; for (int r = 1; r < 16; ++r) pmax = fmaxf(pmax, p0[r]); for (int r = 0; r < 16; ++r) pmax = fmaxf(pmax, p1[r]);
    { auto rr = __builtin_amdgcn_permlane32_swap(__float_as_uint(pmax), __float_as_uint(pmax), false, false);
      pmax = fmaxf(__uint_as_float(rr[0]), __uint_as_float(rr[1])); }
    constexpr float C2 = 1.4426950408889634f * SCALE;
    if (__builtin_expect(__all((pmax - m_reg) * SCALE <= THR), 1)) { mn = m_reg; alpha = 1.f; }
    else { mn = fmaxf(m_reg, pmax); alpha = __builtin_amdgcn_exp2f((m_reg - mn) * C2); m_reg = mn; }
    const float mnL = -mn * C2;
    for (int r = 0; r < 16; ++r) p0[r] = fmaf(p0[r], C2, mnL); for (int r = 0; r < 16; ++r) p1[r] = fmaf(p1[r], C2, mnL);
    for (int r = 0; r < 16; ++r) p0[r] = __builtin_amdgcn_exp2f(p0[r]);
}
__device__ __forceinline__ void finishSM(f32x16& p0, f32x16& p1, float alpha, float& l_reg, bf16x8& pa0, bf16x8& pa1, bf16x8& pa2, bf16x8& pa3) {
    for (int r = 0; r < 16; ++r) p1[r] = __builtin_amdgcn_exp2f(p1[r]);
    float ps = 0; for (int r = 0; r < 16; ++r) ps += p0[r]; for (int r = 0; r < 16; ++r) ps += p1[r];
    { auto rr = __builtin_amdgcn_permlane32_swap(__float_as_uint(ps), __float_as_uint(ps), false, false);
      ps = __uint_as_float(rr[0]) + __uint_as_float(rr[1]); }
    l_reg = l_reg * alpha + ps;
#define PK4(P, B_, OUT) do { unsigned a0 = cvtpk(P[B_+0], P[B_+1]), a1 = cvtpk(P[B_+2], P[B_+3]);                          \
        unsigned b0 = cvtpk(P[B_+4], P[B_+5]), b1 = cvtpk(P[B_+6], P[B_+7]);                                             \
        auto r0 = __builtin_amdgcn_permlane32_swap(a0, b0, false, false); auto r1 = __builtin_amdgcn_permlane32_swap(a1, b1, false, false); \
        u32x4 w = {r0[0], r1[0], r0[1], r1[1]}; OUT = *reinterpret_cast<bf16x8*>(&w); } while (0)
    PK4(p0, 0, pa0); PK4(p0, 8, pa1); PK4(p1, 0, pa2); PK4(p1, 8, pa3);
#undef PK4
}
template <int KB, bool SK>
__device__ __forceinline__ void qkt(f32x16& p0, f32x16& p1, const char* K_lds, int r32, int hi, const bf16x8* qr, bool act) {
    if (SK && !act) { const float NEG = -__builtin_inff();
#pragma unroll
        for (int r = 0; r < 16; ++r) { p0[r] = NEG; p1[r] = NEG; } return; }
    p0 = f32x16{}; p1 = f32x16{};
    const char* kb[4];
#pragma unroll
    for (int dd = 0; dd < 4; ++dd) kb[dd] = K_lds + KB * SHM_K + KSWZ(r32, (dd * 16 + hi * 8) * 2);
#pragma unroll
    for (int d0 = 0; d0 < 8; ++d0) { const char* a = kb[d0 & 3] + (d0 >> 2) * 128;
        bf16x8 b0 = *reinterpret_cast<const bf16x8*>(a);
        bf16x8 b1 = *reinterpret_cast<const bf16x8*>(a + 32 * 256);
        p0 = __builtin_amdgcn_mfma_f32_32x32x16_bf16(b0, qr[d0], p0, 0, 0, 0);
        p1 = __builtin_amdgcn_mfma_f32_32x32x16_bf16(b1, qr[d0], p1, 0, 0, 0); }
}
template <int VB, bool SK>
__device__ __forceinline__ void pv_tile(f32x16* o, int vb0, bf16x8 pa0, bf16x8 pa1, bf16x8 pa2, bf16x8 pa3, bool act) {
    if (SK && !act) return;
#define TRRD(dst, off) asm volatile("ds_read_b64_tr_b16 %0, %1 offset:%2" : "=&v"(dst) : "v"(vb0), "i"(off) : "memory")
#define PV_D0(d0) do { s16x4 l0, l1, l2, l3, h0, h1, h2, h3; constexpr int b_ = VB * SHM_V + v_rd_off(d0, 0, 0);     \
        TRRD(l0, b_); TRRD(h0, b_ + 2048); TRRD(l1, b_ + 4096); TRRD(h1, b_ + 6144); TRRD(l2, b_ + 8192); TRRD(h2, b_ + 10240); TRRD(l3, b_ + 12288); TRRD(h3, b_ + 14336); \
        asm volatile("s_waitcnt lgkmcnt(0)" ::: "memory"); SBAR();                 \
        o[d0] = __builtin_amdgcn_mfma_f32_32x32x16_bf16(pa0, (bf16x8){l0[0], l0[1], l0[2], l0[3], h0[0], h0[1], h0[2], h0[3]}, o[d0], 0, 0, 0);   \
        o[d0] = __builtin_amdgcn_mfma_f32_32x32x16_bf16(pa1, (bf16x8){l1[0], l1[1], l1[2], l1[3], h1[0], h1[1], h1[2], h1[3]}, o[d0], 0, 0, 0);   \
        o[d0] = __builtin_amdgcn_mfma_f32_32x32x16_bf16(pa2, (bf16x8){l2[0], l2[1], l2[2], l2[3], h2[0], h2[1], h2[2], h2[3]}, o[d0], 0, 0, 0);   \
        o[d0] = __builtin_amdgcn_mfma_f32_32x32x16_bf16(pa3, (bf16x8){l3[0], l3[1], l3[2], l3[3], h3[0], h3[1], h3[2], h3[3]}, o[d0], 0, 0, 0); } while (0)
    PV_D0(0); PV_D0(1); PV_D0(2); PV_D0(3);
#undef PV_D0
#undef TRRD
}

template <class TIn, class TOut> struct BlockRef { const TIn* Q; const TIn* K; const TIn* V; TOut* O; int P0; };
template <class TIn> struct Seam {
    bf16x8 qr[8];
    bf16x8 st_v0, st_v1, st_k0, st_k1; f32x4 sf0, sf1, sf2, sf3;
    f32x4 tq[16];
};
__device__ __forceinline__ int swa_jlo(int P0, int W) { const int lowk = P0 - W + 1; return lowk > 0 ? lowk / KVBLK : 0; }
#define ROW(p, k0, rr) ((p) + (size_t)((k0) + (rr)) * ldkv + sc)
#define VMW() asm volatile("s_waitcnt vmcnt(0)" ::: "memory")
#define VMWN(n) asm volatile("s_waitcnt vmcnt(%0)" :: "i"(n) : "memory")
#define SLOAD_H(Kp, Vp, k0) do { S.st_v0 = load8<TIn>(ROW(Vp, k0, sr)); S.st_v1 = load8<TIn>(ROW(Vp, k0, 32 + sr));              \
                         S.st_k0 = load8<TIn>(ROW(Kp, k0, sr)); S.st_k1 = load8<TIn>(ROW(Kp, k0, 32 + sr)); } while (0)
#define SWRITE_HK(bf) do { *(bf16x8*)(K_lds + (bf) * SHM_K + kws) = S.st_k0; *(bf16x8*)(K_lds + (bf) * SHM_K + kws + 32 * 256) = S.st_k1; } while (0)
#define SWRITE_HV(bf) do { *(bf16x8*)(V_lds + (bf) * SHM_V + vst0) = S.st_v0; *(bf16x8*)(V_lds + (bf) * SHM_V + vst1) = S.st_v1; } while (0)
#define SWRITE_H(bf) do { SWRITE_HV(bf); SWRITE_HK(bf); } while (0)
#define SLOAD_F(p, k0) do { S.sf0 = *(const f32x4*)ROW(p, k0, sr); S.sf1 = *(const f32x4*)(ROW(p, k0, sr) + 4);                \
                            S.sf2 = *(const f32x4*)ROW(p, k0, 32 + sr); S.sf3 = *(const f32x4*)(ROW(p, k0, 32 + sr) + 4); } while (0)
#define SWRITE_KF(bf) do { *(bf16x8*)(K_lds + (bf) * SHM_K + kws) = pack8(S.sf0, S.sf1); *(bf16x8*)(K_lds + (bf) * SHM_K + kws + 32 * 256) = pack8(S.sf2, S.sf3); } while (0)
#define SWRITE_VF(bf) do { *(bf16x8*)(V_lds + (bf) * SHM_V + vst0) = pack8(S.sf0, S.sf1); *(bf16x8*)(V_lds + (bf) * SHM_V + vst1) = pack8(S.sf2, S.sf3); } while (0)
template <class TIn, class TOut, class LD>
__device__ __forceinline__ void causal_swa_prime(const BlockRef<TIn, TOut>& cur, int W, char* lds, Seam<TIn>& S, const LD&) {
    constexpr int ldq = LD::q, ldkv = LD::kv; (void)ldq;
    constexpr bool F32 = same_t<TIn, float>::v;
    const int tid = opaque_tid(), wid = __builtin_amdgcn_readfirstlane(tid >> 6), lane = tid & 63, r32 = lane & 31, hi = lane >> 5;
    const int sr = tid >> 4, sc = (tid & 15) * 8, kws = KSWZ(sr, sc * 2); char* K_lds = lds + 2 * SHM_V;
    const int kb0 = swa_jlo(cur.P0, W) * KVBLK;
    for (int d0 = 0; d0 < 8; ++d0) S.qr[d0] = load8<TIn>(cur.Q + (size_t)(wid * QBLK + r32) * ldq + d0 * 16 + hi * 8);
    if constexpr (F32) { SLOAD_F((const float*)cur.K, kb0); VMW(); SWRITE_KF(0); SBAR(); SLOAD_F((const float*)cur.V, kb0); }
    else { SLOAD_H(cur.K, cur.V, kb0); VMW(); SWRITE_HK(0); }
    __syncthreads();
}
template <class TIn, class TOut, class LD>
__device__ __forceinline__ void causal_swa_block(const BlockRef<TIn, TOut>& cur, const BlockRef<TIn, TOut>& nxt, int skv, int W, char* lds, Seam<TIn>& S, const LD&) {
    constexpr int ldq = LD::q, ldkv = LD::kv, ldo = LD::o;
    constexpr bool F32 = same_t<TIn, float>::v;
    const int tid = opaque_tid(), wid = __builtin_amdgcn_readfirstlane(tid >> 6), lane = tid & 63, r32 = lane & 31, hi = lane >> 5;
    const int j_lo = swa_jlo(cur.P0, W);
    int j_hi = (cur.P0 + QB - 1) / KVBLK + 1; if (j_hi > skv / KVBLK) j_hi = skv / KVBLK;
    const int NT = j_hi - j_lo;
    const int kbn = swa_jlo(nxt.P0, W) * KVBLK;
    const int qlo = cur.P0 + wid * QBLK, qm = qlo + r32 - 4 * hi;
    char* V_lds = lds; char* K_lds = lds + 2 * SHM_V;
    float* ws = (float*)(lds + 2 * SHM_V + 2 * SHM_K) + wid * 64; float* li_l = ws, * al_l = ws + 32;
    float m_reg = -1e30f, l_reg = 0; f32x16 o[4] = {};
    const int sr = tid >> 4, sc = (tid & 15) * 8, vst0 = v_st(sr, sc), vst1 = v_st(32 + sr, sc), kws = KSWZ(sr, sc * 2);
    const int vb0 = (int)(uintptr_t)V_lds + v_rd_base(lane);
    const TIn* Kh = cur.K; const TIn* Vh = cur.V;
#define RESC(a) do { if (__any((a) < 1.f)) { if (hi == 0) al_l[r32] = (a); asm volatile("s_waitcnt lgkmcnt(0)" ::: "memory");              \
                     for (int d_ = 0; d_ < 4; ++d_) for (int r = 0; r < 16; ++r) o[d_][r] *= al_l[crow(r, hi)]; } } while (0)
#define KBASE(t) ((j_lo + (t)) * KVBLK)
#define ACT(t) (KBASE(t) <= qlo + QBLK - 1 && KBASE(t) + KVBLK - 1 >= qlo - W + 1)
#define MASKT(P0_, P1_, t) do { const int kb_ = KBASE(t); if ((!SK || ACT(t)) && (kb_ + KVBLK - 1 > qlo || kb_ <= qlo + QBLK - 1 - W)) mask_tile(P0_, P1_, qm - kb_, (unsigned)W); } while (0)
    constexpr int NQL = F32 ? 16 : 8;
    constexpr bool SK = WSKIP && !F32;
#define SEAM_K0() do { VMWN(NQL); if constexpr (F32) { SWRITE_KF(0); SBAR(); SLOAD_F((const float*)nxt.V, kbn); } else { SWRITE_HK(0); } SBAR(); } while (0)
    f32x16 pA0, pA1, pB0, pB1; float mnA, mnB, alA, alB; bf16x8 pa0, pa1, pa2, pa3;
    if constexpr (F32) { VMW(); SWRITE_VF(0); SBAR(); } else { SWRITE_HV(0); SBAR(); }
    if (NT > 1) { if constexpr (F32) SLOAD_F((const float*)Kh, KBASE(1)); else SLOAD_H(Kh, Vh, KBASE(1)); }
    SBAR(); qkt<0, SK>(pA0, pA1, K_lds, r32, hi, S.qr, ACT(0));
    if constexpr (F32) { if (NT > 1) { VMW(); SWRITE_KF(1); SBAR(); SLOAD_F((const float*)Vh, KBASE(1)); } }
    MASKT(pA0, pA1, 0); partialSM(pA0, pA1, m_reg, mnA, alA);
    if (NT > 1) { VMW(); if constexpr (F32) { SWRITE_VF(1); SBAR(); if (NT > 2) SLOAD_F((const float*)Kh, KBASE(2)); } else SWRITE_H(1); }
    __syncthreads();
#define HALF_STEP(PX0, PX1, mnX, alX, PY0, PY1, alY, t, KB, VB, SB) do {                                                      \
        SBAR(); qkt<KB, SK>(PX0, PX1, K_lds, r32, hi, S.qr, ACT(t));                                             \
        finishSM(PY0, PY1, alY, l_reg, pa0, pa1, pa2, pa3); SBAR();                                                           \
        if ((t) + 1 < NT) { if constexpr (F32) { VMW(); SWRITE_KF(SB); SBAR(); SLOAD_F((const float*)Vh, KBASE((t) + 1)); }  \
                            else { SLOAD_H(Kh, Vh, KBASE((t) + 1)); } SBAR(); }                                               \
        pv_tile<VB, SK>(o, vb0, pa0, pa1, pa2, pa3, ACT((t) - 1)); MASKT(PX0, PX1, (t)); partialSM(PX0, PX1, m_reg, mnX, alX);                                        \
        __syncthreads();                                                                                                      \
        if ((t) + 1 < NT) { VMW(); if constexpr (F32) { SWRITE_VF(SB); SBAR(); if ((t) + 2 < NT) SLOAD_F((const float*)Kh, KBASE((t) + 2)); } \
                            else { SWRITE_H(SB); } }                                                                          \
        RESC(alX); __syncthreads(); } while (0)
    for (int t = 1; t + 1 < NT; t += 2) {
        HALF_STEP(pB0, pB1, mnB, alB, pA0, pA1, alA, t, 1, 0, 0);
        HALF_STEP(pA0, pA1, mnA, alA, pB0, pB1, alB, t + 1, 0, 1, 1);
    }
    const bool even = (NT & 1) == 0;
    if (even) { SBAR(); qkt<1, SK>(pB0, pB1, K_lds, r32, hi, S.qr, ACT(NT - 1)); SBAR(); }
#define QROW(e) (nxt.Q + (size_t)(wid * QBLK + r32) * ldq + ((e) >> 1) * 16 + hi * 8 + ((e) & 1) * 4)
    if constexpr (F32) { SLOAD_F((const float*)nxt.K, kbn); SBAR();
#pragma unroll
        for (int e = 0; e < 8; ++e) S.tq[e] = *(const f32x4*)QROW(e); }
    else { SLOAD_H(nxt.K, nxt.V, kbn); SBAR();
#pragma unroll
        for (int d0 = 0; d0 < 8; ++d0) S.qr[d0] = load8<TIn>(nxt.Q + (size_t)(wid * QBLK + r32) * ldq + d0 * 16 + hi * 8); }
    SBAR();
    finishSM(pA0, pA1, alA, l_reg, pa0, pa1, pa2, pa3); SBAR();
    if constexpr (F32) {
#pragma unroll
        for (int e = 8; e < 16; ++e) S.tq[e] = *(const f32x4*)QROW(e); SBAR(); }
#undef QROW
    pv_tile<0, SK>(o, vb0, pa0, pa1, pa2, pa3, ACT(even ? NT - 2 : NT - 1));
    if (even) { MASKT(pB0, pB1, NT - 1); partialSM(pB0, pB1, m_reg, mnB, alB); __syncthreads(); RESC(alB);
        finishSM(pB0, pB1, alB, l_reg, pa0, pa1, pa2, pa3); SBAR(); pv_tile<1, SK>(o, vb0, pa0, pa1, pa2, pa3, ACT(NT - 1)); }
    SBAR(); SEAM_K0();
    if (hi == 0) li_l[r32] = l_reg; asm volatile("s_waitcnt lgkmcnt(0)" ::: "memory");
    float rli[16];
#pragma unroll
    for (int r = 0; r < 16; ++r) rli[r] = __builtin_amdgcn_rcpf(li_l[crow(r, hi)]);
    TOut* Ow = cur.O + (size_t)(wid * QBLK) * ldo;
#pragma unroll
    for (int r = 0; r < 16; ++r) { const int orow = crow(r, hi);
#pragma unroll
        for (int d0 = 0; d0 < 4; ++d0) { const float v = o[d0][r] * rli[r];
            if constexpr (same_t<TOut, float>::v) { Ow[(size_t)orow * ldo + d0 * 32 + r32] = v; }
            else { const float vn = lane_xor1(v);
                   if ((r32 & 1) == 0) *(unsigned*)(Ow + (size_t)orow * ldo + d0 * 32 + r32) = cvtpk(v, vn); } } }
    if constexpr (F32) {
#pragma unroll
        for (int d0 = 0; d0 < 8; ++d0) S.qr[d0] = pack8(S.tq[2 * d0], S.tq[2 * d0 + 1]); }
    __syncthreads();
#undef RESC
#undef KBASE
#undef ACT
#undef MASKT
#undef SEAM_K0
#undef HALF_STEP
}
#undef ROW
#undef VMW
#undef VMWN
#undef SLOAD_H
#undef SWRITE_HK
#undef SWRITE_HV
#undef SWRITE_H
#undef SLOAD_F
#undef SWRITE_KF
#undef SWRITE_VF
#undef KSWZ
#undef SBAR
}

#define LAS __attribute__((address_space(3)))
#define XB_TMO      128
#define XB_XCNT(j)  (256  + 64 * (j))
#define XB_XSUB(j)  (1280 + 64 * (j))
#define XB_XGEN(j)  (2304 + 64 * (j))
#define XB_TOP      3328
#define XB_TOPGEN   3392
#define XCD_BAR_WORDS 3456
#define XB_SPIN_CAP (1u << 18)

__device__ __forceinline__ unsigned xb_ld(unsigned* p)              { return __hip_atomic_load(p, __ATOMIC_RELAXED, __HIP_MEMORY_SCOPE_AGENT); }
__device__ __forceinline__ unsigned xb_add(unsigned* p, unsigned v) { return __hip_atomic_fetch_add(p, v, __ATOMIC_RELAXED, __HIP_MEMORY_SCOPE_AGENT); }
__device__ __forceinline__ unsigned xb_xcc_id() { return (unsigned)__builtin_amdgcn_s_getreg((3 << 11) | 20) & 0xFu; }
#define XB_SPIN(cond, bar) do { unsigned _sp = 0; while (cond) { __builtin_amdgcn_s_sleep(1); \
    if ((++_sp & 255u) == 0u) { if (xb_ld(&(bar)[XB_TMO])) break; if (_sp > XB_SPIN_CAP) { atomicAdd(&(bar)[XB_TMO], 1u); break; } } } } while (0)

struct XcdBarrier {
    unsigned* bar; unsigned x;
    volatile LAS unsigned* st;
};

__device__ __forceinline__ XcdBarrier xcd_barrier_post(unsigned* bar, volatile LAS unsigned* st) {
    XcdBarrier b; b.bar = bar; b.x = xb_xcc_id(); b.st = st;
    if (threadIdx.x == 0) (void)xb_add(&bar[XB_XCNT(b.x)], 1u);
    return b;
}
__device__ __forceinline__ void xcd_barrier_complete(unsigned* bar, unsigned x, unsigned& nloc, unsigned& nx) {
    const unsigned G = gridDim.x * gridDim.y * gridDim.z;
    unsigned sum, cnt, mine, sp = 0u;
    for (;;) {
        sum = 0u; cnt = 0u; mine = 0u;
#pragma unroll
        for (unsigned j = 0; j < 16; ++j) { const unsigned c = xb_ld(&bar[XB_XCNT(j)]); sum += c; cnt += (c > 0u) ? 1u : 0u; mine = (j == x) ? c : mine; }
        if (sum == G) break;
        __builtin_amdgcn_s_sleep(1);
        if ((++sp & 255u) == 0u) { if (xb_ld(&bar[XB_TMO])) break; if (sp > XB_SPIN_CAP) { atomicAdd(&bar[XB_TMO], 1u); break; } }
    }
    nloc = mine > 0u ? mine : 1u; nx = cnt > 0u ? cnt : 1u;
}

__device__ __forceinline__ void xcd_barrier(const XcdBarrier& b) {
    asm volatile("s_waitcnt vmcnt(0)" ::: "memory");
    __syncthreads();
    if (threadIdx.x == 0) {
        unsigned* bar = b.bar;
        __builtin_amdgcn_s_waitcnt(0);
        unsigned nloc = b.st[0], nx = b.st[1];
        if (nloc == 0u) { xcd_barrier_complete(bar, b.x, nloc, nx); b.st[0] = nloc; b.st[1] = nx; }
        const unsigned old = xb_add(&bar[XB_XSUB(b.x)], 1u);
        const unsigned gen = old / nloc;
        if (old + 1u == (gen + 1u) * nloc) {
            __builtin_amdgcn_fence(__ATOMIC_RELEASE, "agent");
            asm volatile("s_waitcnt vmcnt(0)" ::: "memory");
            const unsigned og = xb_add(&bar[XB_TOP], 1u);
            const unsigned tg = og / nx;
            if (og + 1u == (tg + 1u) * nx) xb_add(&bar[XB_TOPGEN], 1u);
            else XB_SPIN(xb_ld(&bar[XB_TOPGEN]) == tg, bar);
            __builtin_amdgcn_fence(__ATOMIC_ACQUIRE, "agent");
            xb_add(&bar[XB_XGEN(b.x)], 1u);
            asm volatile("s_waitcnt vmcnt(0)" ::: "memory");
        } else {
            XB_SPIN(xb_ld(&bar[XB_XGEN(b.x)]) == gen, bar);
            __builtin_amdgcn_fence(__ATOMIC_ACQUIRE, "agent");
            asm volatile("s_waitcnt vmcnt(0)" ::: "memory");
        }
    }
    __syncthreads();
}


typedef float f32x4 __attribute__((ext_vector_type(4)));
typedef unsigned u32x4 __attribute__((ext_vector_type(4)));
typedef unsigned u32x2 __attribute__((ext_vector_type(2)));

typedef float f32x2_t __attribute__((ext_vector_type(2))); typedef __bf16 bf16x2_t __attribute__((ext_vector_type(2)));
__device__ __forceinline__ unsigned pkbf(float lo, float hi) { const f32x2_t v = {lo, hi}; const bf16x2_t b = __builtin_convertvector(v, bf16x2_t); return __builtin_bit_cast(unsigned, b); }
__device__ __forceinline__ float bflo(unsigned w) { return __uint_as_float(w << 16); }
__device__ __forceinline__ float bfhi(unsigned w) { return __uint_as_float(w & 0xffff0000u); }
__device__ __forceinline__ float sigmoidf_(float x) { return __builtin_amdgcn_rcpf(1.0f + __builtin_amdgcn_exp2f(-1.4426950408889634f * x)); }
__device__ __forceinline__ float siluf_(float x) { return x * sigmoidf_(x); }
__device__ __forceinline__ u32x4 pack8(f32x4 a, f32x4 b) { u32x4 w; w.x = pkbf(a[0], a[1]); w.y = pkbf(a[2], a[3]); w.z = pkbf(b[0], b[1]); w.w = pkbf(b[2], b[3]); return w; }
__device__ __forceinline__ void unpack8(u32x4 w, f32x4& a, f32x4& b) { a = (f32x4){bflo(w.x), bfhi(w.x), bflo(w.y), bfhi(w.y)}; b = (f32x4){bflo(w.z), bfhi(w.z), bflo(w.w), bfhi(w.w)}; }

typedef unsigned long long u64_t;
__device__ __forceinline__ float rstd_of(const u64_t* ss, int row) {
    if (!ss) return 1.0f;
    const u64_t v = ss[row]; const float s = ((float)(unsigned)(v >> 32) * 4294967296.0f + (float)(unsigned)v) * (1.0f / 4096.0f);
    return 1.0f / sqrtf(s * (1.0f / DM) + RMS_EPS);
}
__device__ __forceinline__ const void* karg_in(int i);
__device__ __forceinline__ float sum_rows4(float v) {
    { auto rr = __builtin_amdgcn_permlane16_swap(__float_as_uint(v), __float_as_uint(v), false, false); v = __uint_as_float(rr[0]) + __uint_as_float(rr[1]); }
    { auto rr = __builtin_amdgcn_permlane32_swap(__float_as_uint(v), __float_as_uint(v), false, false); v = __uint_as_float(rr[0]) + __uint_as_float(rr[1]); }
    return v;
}
enum { EPI_SWIGLU = 0, EPI_RESID = 1, EPI_MIXIN = 2, EPI_MERGE_A = 3, EPI_MERGE_B = 4, EPI_BF16 = 5 };
struct Epi {
    int mode, perm, ldc, scale2;
    int o16, gate16, ss16, base_in;
    unsigned char* ws;
    __device__ __forceinline__ void pre(u64_t (&sv)[8], const pg8::Unit& u, int wr, int fr) const {
        if (mode != EPI_RESID && ss16) { const u64_t* ss_p = (const u64_t*)(ws + ((size_t)ss16 << 16)); LAUNDER_G(ss_p); const int row0 = u.pm * 256 + wr * 64 + fr;
#pragma unroll
            for (int i = 0; i < 8; ++i) sv[i] = ss_p[row0 + (i >> 2) * 128 + (i & 3) * 16];
        } else {
#pragma unroll
            for (int i = 0; i < 8; ++i) sv[i] = 0ull;
        }
    }
    __device__ __forceinline__ void operator()(const f32x4 (&acc)[2][2][4][2], const pg8::Unit& u, int wr, int wc, int fr, int fq, const u64_t (&svp)[8]) const {
        const int row0 = u.pm * 256 + wr * 64 + fr;
#define LAUNDER(p) LAUNDER_G(p)
        u64_t* ss_l = ss16 ? (u64_t*)(ws + ((size_t)ss16 << 16)) : nullptr; LAUNDER(ss_l); u64_t* const ss_out = ss_l;
        float rs[2][4];
        if (mode != EPI_RESID && ss_l) {
#pragma unroll
            for (int ai = 0; ai < 2; ++ai)
#pragma unroll
                for (int m = 0; m < 4; ++m) { const u64_t v = svp[ai * 4 + m]; const float s = ((float)(unsigned)(v >> 32) * 4294967296.0f + (float)(unsigned)v) * (1.0f / 4096.0f); rs[ai][m] = 1.0f / sqrtf(s * (1.0f / DM) + RMS_EPS); }
        } else {
#pragma unroll
            for (int ai = 0; ai < 2; ++ai)
#pragma unroll
                for (int m = 0; m < 4; ++m) rs[ai][m] = 1.0f;
        }
        if (mode == EPI_RESID) {
            const float* xin = (const float*)karg_in(0); bf16_t* XNB = (bf16_t*)(ws + WS_XN); LAUNDER(xin); LAUNDER(XNB);
            const int col0 = u.pn * 256 + wc * 32 + 4 * fq; const float scale = 0.5f * (float)scale2;
#pragma unroll
            for (int ai = 0; ai < 2; ++ai)
#pragma unroll
              for (int mh = 0; mh < 2; ++mh) {
                f32x4 pre[2][2][2];
                if (base_in) {
#pragma unroll
                    for (int mm = 0; mm < 2; ++mm) { const size_t off = (size_t)(row0 + ai * 128 + (2 * mh + mm) * 16) * DM + col0;
#pragma unroll
                        for (int bj = 0; bj < 2; ++bj)
#pragma unroll
                            for (int n = 0; n < 2; ++n) pre[mm][bj][n] = *(const f32x4*)(xin + off + bj * 128 + n * 16); }
                } else {
                    u32x2 raw[2][2][2];
#pragma unroll
                    for (int mm = 0; mm < 2; ++mm) { const size_t off = (size_t)(row0 + ai * 128 + (2 * mh + mm) * 16) * DM + col0;
#pragma unroll
                        for (int bj = 0; bj < 2; ++bj)
#pragma unroll
                            for (int n = 0; n < 2; ++n) raw[mm][bj][n] = *(const u32x2*)(XNB + off + bj * 128 + n * 16); }
#pragma unroll
                    for (int mm = 0; mm < 2; ++mm)
#pragma unroll
                        for (int bj = 0; bj < 2; ++bj)
#pragma unroll
                            for (int n = 0; n < 2; ++n) { const u32x2 t = raw[mm][bj][n]; pre[mm][bj][n] = (f32x4){bflo(t.x), bfhi(t.x), bflo(t.y), bfhi(t.y)}; }
                }
#pragma unroll
                for (int mm = 0; mm < 2; ++mm) { const int m = 2 * mh + mm; const int row = row0 + ai * 128 + m * 16; const size_t off = (size_t)row * DM + col0; float s = 0.f;
#pragma unroll
                    for (int bj = 0; bj < 2; ++bj)
#pragma unroll
                        for (int n = 0; n < 2; ++n) { const f32x4 v = pre[mm][bj][n] + acc[ai][bj][m][n] * scale;
                            u32x2 w; w.x = pkbf(v[0], v[1]); w.y = pkbf(v[2], v[3]); *(u32x2*)(XNB + off + bj * 128 + n * 16) = w;
                            s += (v[0] * v[0] + v[1] * v[1]) + (v[2] * v[2] + v[3] * v[3]); }
                    s = sum_rows4(s);
                    if (fq == 0) __hip_atomic_fetch_add(ss_out + row, (u64_t)(unsigned)(s * 4096.0f + 0.5f), __ATOMIC_RELAXED, __HIP_MEMORY_SCOPE_AGENT); }
                asm volatile("" ::: "memory");
              }
        } else if (mode == EPI_SWIGLU) {
            bf16_t* O = (bf16_t*)(ws + ((size_t)o16 << 16)); LAUNDER(O);
            const int col = u.pn * 128 + wc * 32 + 8 * fq;
#pragma unroll
            for (int ai = 0; ai < 2; ++ai)
#pragma unroll
                for (int m = 0; m < 4; ++m) { const size_t row = (size_t)(row0 + ai * 128 + m * 16);
                    f32x4 h0, h1;
#pragma unroll
                    for (int e = 0; e < 4; ++e) { const float r = rs[ai][m]; h0[e] = siluf_(acc[ai][0][m][0][e] * r) * (acc[ai][1][m][0][e] * r); h1[e] = siluf_(acc[ai][0][m][1][e] * r) * (acc[ai][1][m][1][e] * r); }
                    *(u32x4*)(O + row * ldc + col) = pack8(h0, h1); }
        } else if (mode == EPI_BF16) {
            bf16_t* O = (bf16_t*)(ws + ((size_t)o16 << 16)); LAUNDER(O);
            const int col0 = u.pn * 256 + wc * 32 + 8 * fq;
#pragma unroll
            for (int ai = 0; ai < 2; ++ai)
#pragma unroll
                for (int m = 0; m < 4; ++m) { const size_t row = (size_t)(row0 + ai * 128 + m * 16);
#pragma unroll
                    for (int bj = 0; bj < 2; ++bj) *(u32x4*)(O + row * ldc + col0 + bj * 128) = pack8(acc[ai][bj][m][0] * rs[ai][m], acc[ai][bj][m][1] * rs[ai][m]); }
        } else if (mode == EPI_MERGE_A || mode == EPI_MERGE_B) {
            bf16_t* O = (bf16_t*)(ws + ((size_t)o16 << 16)); const bf16_t* gate = (const bf16_t*)(ws + ((size_t)gate16 << 16)); LAUNDER(O); LAUNDER(gate);
            const int col0 = u.pn * 256 + wc * 32 + 8 * fq;
#pragma unroll
            for (int ai = 0; ai < 2; ++ai)
#pragma unroll
              for (int mh = 0; mh < 2; ++mh) {
                u32x4 gv[2][2], pv[2][2];
#pragma unroll
                for (int mm = 0; mm < 2; ++mm) { const size_t off = (size_t)(row0 + ai * 128 + (2 * mh + mm) * 16) * DM + col0;
#pragma unroll
                    for (int bj = 0; bj < 2; ++bj) gv[mm][bj] = *(const u32x4*)(gate + off + bj * 128); }
                if (mode == EPI_MERGE_B) {
#pragma unroll
                    for (int mm = 0; mm < 2; ++mm) { const size_t off = (size_t)(row0 + ai * 128 + (2 * mh + mm) * 16) * DM + col0;
#pragma unroll
                        for (int bj = 0; bj < 2; ++bj) pv[mm][bj] = *(const u32x4*)(O + off + bj * 128); }
                } else {
#pragma unroll
                    for (int mm = 0; mm < 2; ++mm)
#pragma unroll
                        for (int bj = 0; bj < 2; ++bj) pv[mm][bj] = (u32x4){0u, 0u, 0u, 0u};
                }
#pragma unroll
                for (int mm = 0; mm < 2; ++mm) { const int m = 2 * mh + mm; const size_t off = (size_t)(row0 + ai * 128 + m * 16) * DM + col0;
#pragma unroll
                    for (int bj = 0; bj < 2; ++bj) { f32x4 g0, g1, p0, p1; unpack8(gv[mm][bj], g0, g1); unpack8(pv[mm][bj], p0, p1);
                        *(u32x4*)(O + off + bj * 128) = pack8(acc[ai][bj][m][0] * g0 + p0, acc[ai][bj][m][1] * g1 + p1); } }
                asm volatile("" ::: "memory");
              }
        } else {
            const int pn = u.pn, tc = wc * 32 + 8 * fq;
            if (pn < 8) {
                bf16_t* G = (bf16_t*)(ws + WS_G); LAUNDER(G);
#pragma unroll
                for (int ai = 0; ai < 2; ++ai)
#pragma unroll
                    for (int m = 0; m < 4; ++m) { const size_t row = (size_t)(row0 + ai * 128 + m * 16);
                        f32x4 h0, h1;
#pragma unroll
                        for (int e = 0; e < 4; ++e) { const float r = rs[ai][m]; h0[e] = acc[ai][0][m][0][e] * r * sigmoidf_(acc[ai][1][m][0][e] * r); h1[e] = acc[ai][0][m][1][e] * r * sigmoidf_(acc[ai][1][m][1][e] * r); }
                        *(u32x4*)(G + row * 1024 + pn * 128 + tc) = pack8(h0, h1); }
            } else if (pn < 16) {
                const int t = pn - 8, h = t & 3, mp = wc >> 1, d0 = (wc & 1) * 32 + 8 * fq;
                bf16_t* qk = (bf16_t*)(ws + (t >= 4 ? WS_K : WS_Q)); const float* cosT = (const float*)(ws + WS_COS); const float* sinT = (const float*)(ws + WS_SIN); LAUNDER(qk); LAUNDER(cosT); LAUNDER(sinT);
                bf16_t* dst = qk + h * 256 + mp * 128 + d0;
#pragma unroll
                for (int ai = 0; ai < 2; ++ai)
#pragma unroll
                    for (int m = 0; m < 4; ++m) { const size_t row = (size_t)(row0 + ai * 128 + m * 16);
                        const f32x4 c0 = *(const f32x4*)(cosT + row * 64 + d0), c1 = *(const f32x4*)(cosT + row * 64 + d0 + 4);
                        const f32x4 s0 = *(const f32x4*)(sinT + row * 64 + d0), s1 = *(const f32x4*)(sinT + row * 64 + d0 + 4);
                        const float r = rs[ai][m]; const f32x4 a0 = acc[ai][0][m][0] * r, a1 = acc[ai][0][m][1] * r, b0 = acc[ai][1][m][0] * r, b1 = acc[ai][1][m][1] * r;
                        *(u32x4*)(dst + row * 1024) = pack8(a0 * c0 - b0 * s0, a1 * c1 - b1 * s1);
                        *(u32x4*)(dst + row * 1024 + 64) = pack8(b0 * c0 + a0 * s0, b1 * c1 + a1 * s1); }
            } else if (pn < 20) {
                const int h = pn - 16; bf16_t* Vb = (bf16_t*)(ws + WS_V); LAUNDER(Vb);
#pragma unroll
                for (int ai = 0; ai < 2; ++ai)
#pragma unroll
                    for (int m = 0; m < 4; ++m) { const size_t row = (size_t)(row0 + ai * 128 + m * 16);
#pragma unroll
                        for (int bj = 0; bj < 2; ++bj) *(u32x4*)(Vb + row * 1024 + h * 256 + bj * 128 + tc) = pack8(acc[ai][bj][m][0] * rs[ai][m], acc[ai][bj][m][1] * rs[ai][m]); }
            } else {
                bf16_t* gbase = (bf16_t*)(ws + (pn < 28 ? WS_GC : WS_GA)); LAUNDER(gbase);
                bf16_t* dst = gbase + ((pn - 20) & 7) * 256 + tc;
#pragma unroll
                for (int ai = 0; ai < 2; ++ai)
#pragma unroll
                    for (int m = 0; m < 4; ++m) { const size_t row = (size_t)(row0 + ai * 128 + m * 16);
#pragma unroll
                        for (int bj = 0; bj < 2; ++bj) { f32x4 v0, v1;
#pragma unroll
                            for (int e = 0; e < 4; ++e) { v0[e] = sigmoidf_(acc[ai][bj][m][0][e] * rs[ai][m]); v1[e] = sigmoidf_(acc[ai][bj][m][1][e] * rs[ai][m]); }
                            *(u32x4*)(dst + row * DM + bj * 128) = pack8(v0, v1); } }
            }
        }
    }
};

__device__ __forceinline__ int map_ffn_in(int c) { const int half = c >= DFF ? 1 : 0, j = c - half * DFF; return 256 * (j >> 7) + half * 128 + (j & 127); }
__device__ __forceinline__ int map_mix_in(int c) {
    if (c < 2048) { const int half = c >= 1024 ? 1 : 0, j = c - half * 1024; return 256 * (j >> 7) + half * 128 + (j & 127); }
    if (c < 4096) { const int cc = c - 2048, t = cc >> 8, mp = (cc >> 7) & 1, d = cc & 127; return 2048 + 256 * t + (d >> 6) * 128 + mp * 64 + (d & 63); }
    return c;
}
__device__ __forceinline__ void transpose_item(const float* W, int K, int N, bf16_t* WT, int maptype, const float* gain, LAS float* scr, int item, int lane) {
    const int nblk = N / 32, kb = item / nblk, nb = item % nblk, k0 = 64 * kb, n0 = 32 * nb;
    const int drow = maptype == 1 ? map_ffn_in(n0) : (maptype == 2 ? map_mix_in(n0) : n0);
#pragma unroll 8
    for (int i = 0; i < 32; ++i) { const int kk = 2 * i + (lane >> 5); scr[kk * 33 + (lane & 31)] = W[(size_t)(k0 + kk) * N + n0 + (lane & 31)]; }
    asm volatile("s_waitcnt lgkmcnt(0)" ::: "memory");
    const int c = lane & 7;
    f32x4 g0 = {1.f, 1.f, 1.f, 1.f}, g1 = g0;
    if (gain) { g0 = *(const f32x4*)(gain + k0 + 8 * c); g1 = *(const f32x4*)(gain + k0 + 8 * c + 4); }
#pragma unroll
    for (int j = 0; j < 4; ++j) { const int n = (lane >> 3) + 8 * j; const LAS float* s = scr + (8 * c) * 33 + n;
        u32x4 o; o.x = pkbf(s[0 * 33] * g0[0], s[1 * 33] * g0[1]); o.y = pkbf(s[2 * 33] * g0[2], s[3 * 33] * g0[3]); o.z = pkbf(s[4 * 33] * g1[0], s[5 * 33] * g1[1]); o.w = pkbf(s[6 * 33] * g1[2], s[7 * 33] * g1[3]);
        *(u32x4*)(WT + (size_t)(drow + n) * K + k0 + 8 * c) = o; }
    asm volatile("s_waitcnt lgkmcnt(0)" ::: "memory");
}

__device__ __forceinline__ const void* karg_in(int i) {
    int off = i * 8; asm volatile("" : "+s"(off));
    const char __attribute__((address_space(4)))* k = (const char __attribute__((address_space(4)))*)__builtin_amdgcn_kernarg_segment_ptr();
    return *(const void* const __attribute__((address_space(4)))*)(k + off);
}
struct Params {
    const void* in[26];
    float* out;
    unsigned char* ws;
};

__device__ __forceinline__ void wdesc(int id, int& inp, int& K, int& N, size_t& off, int& mt) {
    switch (id) {
        case 0:  inp = 4;  K = DM;   N = 2 * DFF; off = OW_F1I; mt = 1; break;
        case 1:  inp = 5;  K = DFF;  N = DM;      off = OW_F1O; mt = 0; break;
        case 2:  inp = 7;  K = DM;   N = MIXN;    off = OW_MI;  mt = 2; break;
        case 3:  inp = 12; K = 1024; N = DM;      off = OW_WC;  mt = 0; break;
        case 4:  inp = 15; K = 1024; N = DM;      off = OW_WD;  mt = 0; break;
        case 5:  inp = 16; K = DM;   N = DM;      off = OW_MO;  mt = 0; break;
        case 6:  inp = 19; K = DM;   N = MEMW;    off = OW_CQ;  mt = 0; break;
        case 7:  inp = 20; K = DM;   N = 2 * MEMW; off = OW_CKV; mt = 0; break;
        case 8:  inp = 21; K = MEMW; N = DM;      off = OW_CO;  mt = 0; break;
        case 9:  inp = 23; K = DM;   N = 2 * DFF; off = OW_F2I; mt = 1; break;
        default: inp = 24; K = DFF;  N = DM;      off = OW_F2O; mt = 0; break;
    }
}

__device__ __forceinline__ void phase_prologue(const Params& P, LAS unsigned char* lds, int vcu, int NGW) {
    asm volatile("" : "+s"(NGW));
    const int tid = opaque_tid(), lane = tid & 63, wave = __builtin_amdgcn_readfirstlane(tid >> 6), gw = vcu * 8 + wave;
    LAS float* scr = (LAS float*)(lds + wave * 16384);
    constexpr int ITEMS_PER_LAYER = 49152;
    for (int it = gw; it < DEPTH * ITEMS_PER_LAYER; it += NGW) {
        const int layer = it / ITEMS_PER_LAYER; int r = it - layer * ITEMS_PER_LAYER;
        int id = 0;
        for (;;) { int inp, K, N, mt; size_t off; wdesc(id, inp, K, N, off, mt); const int n_it = (K / 64) * (N / 32);
            if (r < n_it) { const int gi = id == 0 ? 3 : (id == 2 ? 6 : (id == 6 ? 17 : (id == 9 ? 22 : -1)));
                const float* gain = (FUSE_NORM && gi >= 0) ? (const float*)karg_in(gi) + layer * DM : nullptr;
                transpose_item((const float*)karg_in(inp) + (size_t)layer * K * N, K, N, (bf16_t*)(P.ws + WS_W + layer * WS_WLAYER) + off, mt, gain, scr, r, lane); break; }
            r -= n_it; ++id; }
    }
    { const float* xin = (const float*)karg_in(0); bf16_t* XN = (bf16_t*)(P.ws + WS_XN); u64_t* SS = (u64_t*)(P.ws + WS_SS);
      for (int m = gw; m < MROWS; m += NGW) {
          const f32x4* xr = (const f32x4*)(xin + (size_t)m * DM) + lane; u32x2* o = (u32x2*)(XN + (size_t)m * DM) + lane; float s = 0.f;
#pragma unroll
          for (int j = 0; j < 8; ++j) { const f32x4 v = xr[64 * j]; s += (v[0] * v[0] + v[1] * v[1]) + (v[2] * v[2] + v[3] * v[3]); u32x2 w; w.x = pkbf(v[0], v[1]); w.y = pkbf(v[2], v[3]); o[64 * j] = w; }
          s = wave_sum(s); if (lane == 0) SS[m] = (u64_t)((double)s * 4096.0); }
      for (int i = gw * 64 + lane; i < 9 * MROWS; i += NGW * 64) SS[MROWS + i] = 0ull;
      const float* mem = (const float*)karg_in(1);
      for (int m = gw; m < DEPTH * NBATCH * MEML; m += NGW) { const int layer = m / (NBATCH * MEML), r = m % (NBATCH * MEML);
          const float* g = (const float*)karg_in(18) + layer * DM;
          const f32x4* xr = (const f32x4*)(mem + (size_t)r * DM) + lane; u32x2* o = (u32x2*)((bf16_t*)(P.ws + WS_MEMN) + (size_t)m * DM) + lane; f32x4 v[8]; float s = 0.f;
#pragma unroll
          for (int j = 0; j < 8; ++j) { v[j] = xr[64 * j]; s += (v[j][0] * v[j][0] + v[j][1] * v[j][1]) + (v[j][2] * v[j][2] + v[j][3] * v[j][3]); }
          const float rr = 1.0f / sqrtf(wave_sum(s) * (1.0f / DM) + RMS_EPS);
#pragma unroll
          for (int j = 0; j < 8; ++j) { const f32x4 t = v[j] * rr * *(const f32x4*)(g + 4 * lane + 256 * j); u32x2 w; w.x = pkbf(t[0], t[1]); w.y = pkbf(t[2], t[3]); o[64 * j] = w; } }
    }
    const int* pos = (const int*)karg_in(2);
    float* cosT = (float*)(P.ws + WS_COS); float* sinT = (float*)(P.ws + WS_SIN);
    for (int idx = gw * 64 + lane; idx < MROWS * 64; idx += NGW * 64) {
        const int row = idx >> 6, i = idx & 63;
        double inv = 1.0;
        for (int k = 0; k < i; ++k) inv *= 0.8659643233600653;
        const float ang = (float)pos[row] * (float)inv;
        const double rev = (double)ang * 0.15915494309189535;
        const float fr = (float)(rev - __builtin_rint(rev));
        cosT[idx] = __builtin_amdgcn_cosf(fr); sinT[idx] = __builtin_amdgcn_sinf(fr);
    }
}

__device__ __forceinline__ void phase_norm(const float* X, const float* g, bf16_t* XN, int nrows, int vcu, int NGW) {
    asm volatile("" : "+s"(NGW));
    const int tid = opaque_tid(), lane = tid & 63, wave = __builtin_amdgcn_readfirstlane(tid >> 6), gw = vcu * 8 + wave;
    f32x4 gv[8];
#pragma unroll
    for (int j = 0; j < 8; ++j) gv[j] = *(const f32x4*)(g + 4 * lane + 256 * j);
    for (int m = gw; m < nrows; m += NGW) {
        const f32x4* xr = (const f32x4*)(X + (size_t)m * DM) + lane;
        f32x4 v[8]; float s = 0.f;
#pragma unroll
        for (int j = 0; j < 8; ++j) { v[j] = xr[64 * j]; s += (v[j][0] * v[j][0] + v[j][1] * v[j][1]) + (v[j][2] * v[j][2] + v[j][3] * v[j][3]); }
        const float r = 1.0f / sqrtf(wave_sum(s) * (1.0f / DM) + RMS_EPS);
        u32x2* o = (u32x2*)(XN + (size_t)m * DM) + lane;
#pragma unroll
        for (int j = 0; j < 8; ++j) { const f32x4 t = v[j] * r * gv[j]; u32x2 w; w.x = pkbf(t[0], t[1]); w.y = pkbf(t[2], t[3]); o[64 * j] = w; }
    }
}
__device__ __forceinline__ void phase_final_norm(const bf16_t* XB, const float* g, float* out, int vcu, int NGW) {
    asm volatile("" : "+s"(NGW));
    const int tid = opaque_tid(), lane = tid & 63, wave = __builtin_amdgcn_readfirstlane(tid >> 6), gw = vcu * 8 + wave;
    f32x4 gv[8];
#pragma unroll
    for (int j = 0; j < 8; ++j) gv[j] = *(const f32x4*)(g + 4 * lane + 256 * j);
    for (int m = gw; m < MROWS; m += NGW) {
        const u32x2* xr = (const u32x2*)(XB + (size_t)m * DM) + lane;
        f32x4 v[8]; float s = 0.f;
#pragma unroll
        for (int j = 0; j < 8; ++j) { const u32x2 t = xr[64 * j]; v[j] = (f32x4){bflo(t.x), bfhi(t.x), bflo(t.y), bfhi(t.y)}; s += (v[j][0] * v[j][0] + v[j][1] * v[j][1]) + (v[j][2] * v[j][2] + v[j][3] * v[j][3]); }
        const float r = 1.0f / sqrtf(wave_sum(s) * (1.0f / DM) + RMS_EPS);
        f32x4* o = (f32x4*)(out + (size_t)m * DM) + lane;
#pragma unroll
        for (int j = 0; j < 8; ++j) o[64 * j] = v[j] * r * gv[j];
    }
}

#ifndef CONV_CT
#define CONV_CT 16
#endif
__device__ __forceinline__ void phase_conv(const bf16_t* G, const float* cw, const float* cb, const float* lg, const float* lb, bf16_t* YC, LAS unsigned char* lds) {
    constexpr int CT = CONV_CT;
    const int tid = opaque_tid(), lane = tid & 63, wave = tid >> 6;
    typedef float f32x2 __attribute__((ext_vector_type(2)));
    f32x2 w[CONV_K];
#pragma unroll
    for (int j = 0; j < CONV_K; ++j) w[j] = *(const f32x2*)(cw + j * CONV_CH + 2 * tid);
    const f32x2 bias = *(const f32x2*)(cb + 2 * tid), g2 = *(const f32x2*)(lg + 2 * tid), b2 = *(const f32x2*)(lb + 2 * tid);
    LAS float* red = (LAS float*)lds;
    const int tiles_per_wg = (MROWS / CT + (int)gridDim.x - 1) / (int)gridDim.x;
    for (int tile = blockIdx.x * tiles_per_wg; tile < (blockIdx.x + 1) * tiles_per_wg && tile < MROWS / CT; ++tile) {
        const int b = tile / (SEQ / CT), s0 = (tile % (SEQ / CT)) * CT;
        f32x2 acc[CT];
#pragma unroll
        for (int t = 0; t < CT; ++t) acc[t] = bias;
#pragma unroll
        for (int tp = 0; tp < CT + CONV_K - 1; ++tp) {
            const int s = s0 - (CONV_K - 1) + tp;
            f32x2 v = (f32x2){0.f, 0.f};
            { const unsigned raw = *(const unsigned*)(G + (size_t)(b * SEQ + (s < 0 ? 0 : s)) * CONV_CH + 2 * tid);
              if (s >= 0) v = (f32x2){bflo(raw), bfhi(raw)}; }
#pragma unroll
            for (int t = 0; t < CT; ++t) { const int j = tp - t; if (j >= 0 && j < CONV_K) acc[t] += w[j] * v; }
        }
#pragma unroll
        for (int t = 0; t < CT; ++t) {
            const float p1 = wave_sum(acc[t][0] + acc[t][1]);
            const float p2 = wave_sum(acc[t][0] * acc[t][0] + acc[t][1] * acc[t][1]);
            if (lane == 0) { red[wave * 2 * CT + 2 * t] = p1; red[wave * 2 * CT + 2 * t + 1] = p2; }
        }
        __syncthreads();
        if (tid < 2 * CT) { float s = 0.f;
#pragma unroll
            for (int k = 0; k < 8; ++k) s += red[k * 2 * CT + tid];
            red[512 + tid] = s; }
        __syncthreads();
#pragma unroll
        for (int t = 0; t < CT; ++t) {
            const float mean = red[512 + 2 * t] * (1.0f / CONV_CH);
            const float var = red[512 + 2 * t + 1] * (1.0f / CONV_CH) - mean * mean;
            const float r = 1.0f / sqrtf(var + LN_EPS);
            const float y0 = (acc[t][0] - mean) * r * g2[0] + b2[0], y1 = (acc[t][1] - mean) * r * g2[1] + b2[1];
            *(unsigned*)(YC + (size_t)(b * SEQ + s0 + t) * CONV_CH + 2 * tid) = pkbf(siluf_(y0), siluf_(y1));
        }
        __syncthreads();
    }
}

__device__ __forceinline__ void phase_combine(const bf16_t* O, const float* lamp, const float* subg, bf16_t* OC, int layer, int vcu, int NGW) {
    asm volatile("" : "+s"(NGW));
    const int tid = opaque_tid(), lane = tid & 63, wave = __builtin_amdgcn_readfirstlane(tid >> 6), gw = vcu * 8 + wave;
    const float lam_init = layer == 0 ? 0.2f : 0.35550906759096934f;
    const float d1 = wave_sum(lamp[lane] * lamp[128 + lane] + lamp[64 + lane] * lamp[192 + lane]);
    const float d2 = wave_sum(lamp[256 + lane] * lamp[384 + lane] + lamp[320 + lane] * lamp[448 + lane]);
    const float lam = expf(d1) - expf(d2) + lam_init;
    const f32x4 gv = *(const f32x4*)(subg + 4 * lane);
    const float post = 1.0f - lam_init;
    for (int it = gw; it < MROWS * 4; it += NGW) {
        const int row = it >> 2, h = it & 3;
        const bf16_t* src = O + (size_t)row * 2048 + h * 512 + 4 * lane;
        const u32x2 a = *(const u32x2*)src, b = *(const u32x2*)(src + 256);
        f32x4 d;
        d[0] = bflo(a.x) - lam * bflo(b.x); d[1] = bfhi(a.x) - lam * bfhi(b.x); d[2] = bflo(a.y) - lam * bflo(b.y); d[3] = bfhi(a.y) - lam * bfhi(b.y);
        const float ss = wave_sum((d[0] * d[0] + d[1] * d[1]) + (d[2] * d[2] + d[3] * d[3]));
        const float r = post / sqrtf(ss * (1.0f / 256.0f) + RMS_EPS);
        const f32x4 o = d * r * gv;
        u32x2 wv; wv.x = pkbf(o[0], o[1]); wv.y = pkbf(o[2], o[3]);
        *(u32x2*)(OC + (size_t)row * 1024 + h * 256 + 4 * lane) = wv;
    }
}

typedef attn::BlockRef<attn::bf16, attn::bf16> ARef;
__device__ __forceinline__ ARef diff_ref(int L, int pass, unsigned char* ws) {
    const int bhs = L >> 4, b = bhs >> 4, sub = bhs & 15, h = sub >> 2, mp = (sub >> 1) & 1, vh = sub & 1, x = L & 15, qb = pass ? x : 31 - x;
    ARef r;
    r.Q = (const attn::bf16*)((const bf16_t*)(ws + WS_Q) + (size_t)(b * SEQ + qb * 256) * 1024 + h * 256 + mp * 128);
    r.K = (const attn::bf16*)((const bf16_t*)(ws + WS_K) + (size_t)(b * SEQ) * 1024 + h * 256 + mp * 128);
    r.V = (const attn::bf16*)((const bf16_t*)(ws + WS_V) + (size_t)(b * SEQ) * 1024 + h * 256 + vh * 128);
    r.O = (attn::bf16*)((bf16_t*)(ws + WS_X) + (size_t)(b * SEQ + qb * 256) * 2048 + h * 512 + mp * 256 + vh * 128);
    r.P0 = qb * 256;
    return r;
}
__device__ __forceinline__ ARef cross_ref(int u, unsigned char* ws) {
    const int b = u >> 7, h = (u >> 5) & 3, qb = u & 31;
    ARef r;
    r.Q = (const attn::bf16*)((const bf16_t*)(ws + WS_CQ) + (size_t)(b * SEQ + qb * 256) * MEMW + h * 128);
    r.K = (const attn::bf16*)((const bf16_t*)(ws + WS_MEMKV) + (size_t)(b * MEML) * 1024 + h * 128);
    r.V = (const attn::bf16*)((const bf16_t*)(ws + WS_MEMKV) + (size_t)(b * MEML) * 1024 + 512 + h * 128);
    r.O = (attn::bf16*)((bf16_t*)(ws + WS_CO) + (size_t)(b * SEQ + qb * 256) * MEMW + h * 128);
    r.P0 = 256;
    return r;
}
template <int KIND>
__device__ __forceinline__ void phase_attn(unsigned char* ws, char* lds, int vcu, int G) {
    constexpr int total = KIND == 0 ? 512 : 256, skv = KIND == 0 ? SEQ : MEML, W = KIND == 0 ? SEQ : (1 << 20);
    typedef attn::AttnLd<(KIND == 0 ? 1024 : MEMW), 1024, (KIND == 0 ? 2048 : MEMW)> LDT;
    const LDT LD{};
    int L = vcu; if (L >= total) return;
    int pass = 0;
    ARef cur = KIND == 0 ? diff_ref(L, 0, ws) : cross_ref(L, ws);
    attn::Seam<attn::bf16> S;
    attn::causal_swa_prime<attn::bf16, attn::bf16, LDT>(cur, W, lds, S, LD);
    for (;;) {
        const bool more_pass = (KIND == 0) && pass == 0, more_item = L + G < total, last = !more_pass && !more_item;
        int passn = pass + 1, Ln = L;
        if (!more_pass) { passn = 0; Ln = more_item ? L + G : L; }
        const ARef nxt = last ? cur : (KIND == 0 ? diff_ref(Ln, passn, ws) : cross_ref(Ln, ws));
        attn::causal_swa_block<attn::bf16, attn::bf16, LDT>(cur, nxt, skv, W, lds, S, LD);
        if (last) break;
        cur = nxt; pass = passn; L = Ln;
    }
}

#ifndef PROBE_STAGE
#define PROBE_STAGE -2
#define PROBE_REP 1
#endif
constexpr int PR_S = PROBE_STAGE, PR_R = PROBE_REP;
constexpr int LAYER_PH = (FUSE_NORM ? 12 : 16) + (PR_S >= 0 ? PR_R : 0), PRO_PH = 1 + (PR_S == -1 ? PR_R : 0);
constexpr int NPHASE = PRO_PH + LAYER_PH * DEPTH + 1;
__global__ void __launch_bounds__(512, 2) mega_fwd(Params P, int ph_lo, int ph_hi) {
    extern __shared__ __attribute__((aligned(16))) unsigned char lds_raw[];
    LAS unsigned char* lds = (LAS unsigned char*)lds_raw;
    cg::grid_group grid = cg::this_grid();
    const int G = gridDim.x, bx = blockIdx.x;
    const int vcu = (G % 8 == 0) ? (bx % 8) * (G / 8) + bx / 8 : bx;
    const int NGW = G * 8;

    volatile LAS unsigned* MISC = (volatile LAS unsigned*)(lds + 131072 + 320);
    { unsigned char* ws = P.ws;
    if (opaque_tid() < 32) MISC[opaque_tid()] = 0u;
    __syncthreads();
    if (ph_hi - ph_lo > 1) { (void)xcd_barrier_post((unsigned*)(ws + WS_CTL), MISC + 8); if (ph_lo < 0) grid.sync(); } }
    for (int ph = ph_lo; ph < ph_hi; ++ph) {
        unsigned char* ws = P.ws; LAUNDER_G(ws);
        float* X = (float*)(ws + WS_X); bf16_t* XN = (bf16_t*)(ws + WS_XN); bf16_t* HID = (bf16_t*)(ws + WS_HID);
        int layer = 0, stage = -1; bool dup = false;
        if (ph == NPHASE - 1) { stage = 16; layer = DEPTH; }
        else if (ph >= PRO_PH) { layer = (ph - PRO_PH) / LAYER_PH; const int q = (ph - PRO_PH) % LAYER_PH;
            int qs;
            if (PR_S < 0 || q < PR_S) qs = q; else if (q <= PR_S + PR_R) { qs = PR_S; dup = q < PR_S + PR_R; } else qs = q - PR_R;
            stage = FUSE_NORM ? qs + 1 + (qs >= 2 ? 1 : 0) + (qs >= 7 ? 1 : 0) + (qs >= 10 ? 1 : 0) : qs; }
        const bf16_t* WL = (const bf16_t*)(ws + WS_W + (size_t)layer * WS_WLAYER);
        const float* xcur = (layer == 0 && stage <= 2) ? (const float*)karg_in(0) : X;
        int ngemm = 0;
        if (stage == -1) {
#ifndef SKIP_PRO
            phase_prologue(P, lds, vcu, NGW);
#endif
        } else if (stage == 16) {
            phase_final_norm(XN, (const float*)karg_in(25), P.out, vcu, NGW);
        } else if (!FUSE_NORM && (stage == 0 || stage == 3 || stage == 9 || stage == 13)) {
            const int gi = stage == 0 ? 3 : (stage == 3 ? 6 : (stage == 9 ? 17 : 22));
            phase_norm(xcur, (const float*)karg_in(gi) + layer * DM, XN, MROWS, vcu, NGW);
        } else if (stage == 5) {
#ifndef SKIP_CONV
            phase_conv((const bf16_t*)(ws + WS_G), (const float*)karg_in(8) + layer * CONV_K * CONV_CH, (const float*)karg_in(9) + layer * CONV_CH,
                       (const float*)karg_in(10) + layer * CONV_CH, (const float*)karg_in(11) + layer * CONV_CH, (bf16_t*)(ws + WS_YC), lds);
#endif
#if !defined(SKIP_ATTN) && !defined(SKIP_ATTN0)
            phase_attn<0>(ws, (char*)lds_raw, vcu, G);
#endif
        } else if (stage == 6) {
            phase_combine((const bf16_t*)(ws + WS_X), (const float*)karg_in(13) + layer * 512, (const float*)karg_in(14) + layer * 256, (bf16_t*)(ws + WS_OC), layer, vcu, NGW);
        } else if (stage == 11) {
#if !defined(SKIP_ATTN) && !defined(SKIP_ATTN1)
            phase_attn<1>(ws, (char*)lds_raw, vcu, G);
#endif
        } else {
            ngemm = (stage == 7 || stage == 10) ? 2 : 1;
        }
        for (int pass = 0; pass < ngemm; ++pass) {
            pg8::Gemm g; Epi E; int cblk = bx;
            E.mode = EPI_BF16; E.perm = 1; E.ldc = 0; E.scale2 = 2; E.o16 = 0; E.gate16 = 0; E.ss16 = 0; E.base_in = 0; E.ws = ws;
            constexpr int SS16 = (int)(WS_SS >> 16);
            g.M = MROWS;
            if (stage == 1 || stage == 14) { g.A = XN; g.Bt = WL + (stage == 1 ? OW_F1I : OW_F2I); g.N = 2 * DFF; g.K = DM; E.mode = EPI_SWIGLU; E.o16 = (int)(WS_HID >> 16); E.ldc = DFF; E.ss16 = FUSE_NORM ? SS16 + 2 * (stage == 1 ? 4 * layer : 3 + 4 * layer) : 0; }
            else if (stage == 2 || stage == 15) { g.A = HID; g.Bt = WL + (stage == 2 ? OW_F1O : OW_F2O); g.N = DM; g.K = DFF; E.mode = EPI_RESID; E.perm = 0; E.base_in = (layer == 0 && stage == 2) ? 1 : 0; E.scale2 = dup ? 0 : 1; E.ss16 = SS16 + 2 * (dup ? 9 : (stage == 2 ? 1 + 4 * layer : 4 + 4 * layer)); }
            else if (stage == 4) { g.A = XN; g.Bt = WL + OW_MI; g.N = MIXN; g.K = DM; E.mode = EPI_MIXIN; E.ss16 = FUSE_NORM ? SS16 + 2 * (1 + 4 * layer) : 0; }
            else if (stage == 7) { g.A = pass == 0 ? (const bf16_t*)(ws + WS_YC) : (const bf16_t*)(ws + WS_OC); g.Bt = WL + (pass == 0 ? OW_WC : OW_WD); g.N = DM; g.K = 1024;
                                   E.mode = pass == 0 ? EPI_MERGE_A : EPI_MERGE_B; E.gate16 = (int)((pass == 0 ? WS_GC : WS_GA) >> 16); E.o16 = (int)(WS_MERGED >> 16); E.ldc = DM; }
            else if (stage == 8) { g.A = (const bf16_t*)(ws + WS_MERGED); g.Bt = WL + OW_MO; g.N = DM; g.K = DM; E.mode = EPI_RESID; E.perm = 0; E.scale2 = dup ? 0 : 2; E.ss16 = SS16 + 2 * (dup ? 9 : 2 + 4 * layer); }
            else if (stage == 10) {
                if (pass == 0) { g.A = XN; g.Bt = WL + OW_CQ; g.N = MEMW; g.K = DM; E.o16 = (int)(WS_CQ >> 16); E.ldc = MEMW; E.ss16 = FUSE_NORM ? SS16 + 2 * (2 + 4 * layer) : 0; }
                else { g.A = (const bf16_t*)(ws + WS_MEMN) + (size_t)layer * NBATCH * MEML * DM; g.Bt = WL + OW_CKV; g.M = NBATCH * MEML; g.N = 2 * MEMW; g.K = DM; E.o16 = (int)(WS_MEMKV >> 16); E.ldc = 2 * MEMW; cblk = (bx + G - 128) % G; }
            }
            else { g.A = (const bf16_t*)(ws + WS_CO); g.Bt = WL + OW_CO; g.N = DM; g.K = MEMW; E.mode = EPI_RESID; E.perm = 0; E.scale2 = dup ? 0 : 2; E.ss16 = SS16 + 2 * (dup ? 9 : 3 + 4 * layer); }
            pg8::StaticOrder S; S.init(g.M, g.N, G, cblk);
#ifndef SKIP_GEMM
            pg8::gemm_phase<Epi, pg8::StaticOrder, true, true>(lds, g, S, E);
#endif
        }
        if (ph + 1 < ph_hi) {
            XcdBarrier bar; bar.bar = (unsigned*)(ws + WS_CTL); bar.x = xb_xcc_id(); bar.st = (volatile LAS unsigned*)(lds + 131072 + 320) + 8;
            xcd_barrier(bar);
        }
    }
}

extern "C" void kernel_launch(void* const* d_in, const int* in_sizes, int n_in, void* d_out, int out_size, void* d_ws, size_t ws_size, hipStream_t stream) {
    static int grid = 0;
    if (grid == 0) {
        if (n_in != 26 || out_size != MROWS * DM || ws_size < WS_END) { fprintf(stderr, "kernel_launch: unexpected shapes (n_in %d out %d ws %zu, need ws >= %zu); nothing launched\n", n_in, out_size, ws_size, (size_t)WS_END); grid = -1; return; }
        int dev = 0, cus = 0, per_cu = 0;
        (void)hipGetDevice(&dev);
        if (hipDeviceGetAttribute(&cus, hipDeviceAttributeMultiprocessorCount, dev) != hipSuccess || cus <= 0) cus = 256;
        if (hipFuncSetAttribute((const void*)mega_fwd, hipFuncAttributeMaxDynamicSharedMemorySize, LDS_BYTES) != hipSuccess) fprintf(stderr, "kernel_launch: hipFuncSetAttribute failed\n");
        if (hipOccupancyMaxActiveBlocksPerMultiprocessor(&per_cu, (const void*)mega_fwd, 512, LDS_BYTES) != hipSuccess || per_cu < 1) { fprintf(stderr, "kernel_launch: occupancy query says %d\n", per_cu); per_cu = 1; }
        (void)hipGetLastError();
        grid = cus * (per_cu > 1 ? 1 : per_cu);
    }
    if (grid < 0) return;
    if (hipMemsetAsync((char*)d_ws + WS_CTL, 0, CTL_ZERO_BYTES, stream) != hipSuccess) { fprintf(stderr, "kernel_launch: memset of the control words failed\n"); return; }
    Params p{};
    for (int i = 0; i < 26; ++i) p.in[i] = d_in[i];
    p.out = (float*)d_out; p.ws = (unsigned char*)d_ws;
#if MK_PER_PHASE
    for (int ph = 0; ph < NPHASE; ++ph) hipLaunchKernelGGL(mega_fwd, dim3(grid), dim3(512), LDS_BYTES, stream, p, ph, ph + 1);
#else
    int lo = 0, hi = NPHASE;
    void* args[] = {(void*)&p, (void*)&lo, (void*)&hi};
    hipError_t e = hipLaunchCooperativeKernel((const void*)mega_fwd, dim3(grid), dim3(512), args, LDS_BYTES, stream);
    if (e != hipSuccess) fprintf(stderr, "kernel_launch: cooperative launch failed: %s (grid %d)\n", hipGetErrorString(e), grid);
#endif
}
```
